# Optimizing an MI355X kernel written in HIP

```python
import math
import jax, jax.numpy as jnp
from jax import lax
import numpy as np

D_MODEL = 1024
BATCH = 4
SEQ = 4096
DEPTH = 2

N_MIXERS = 2
EXPAND = 2
D_INNER = EXPAND * D_MODEL
EPS = 1e-6

DA_HEADS = 16
DA_HEAD_DIM = D_INNER // (2 * DA_HEADS)
DA_V_DIM = 2 * DA_HEAD_DIM
ROPE_THETA = 10000.0
Q_BLOCK = 128
LAMBDA_STD = 0.1

GLA_HEADS = 4
GLA_DK = D_INNER // 2
GLA_HEAD_K = GLA_DK // GLA_HEADS
GLA_HEAD_V = D_INNER // GLA_HEADS
GLA_GATE_RANK = 16
GLA_GATE_TAU = 16.0
GLA_CHUNK = 64
GLA_IN = 2 * GLA_DK + 2 * D_INNER + GLA_GATE_RANK

N_DIFF = (DEPTH + 1) // 2
N_GLA = DEPTH // 2
ADA_STD = 0.2

kernel_name = "hybrid_diffattn_gla_adaln"


def rmsnorm(x, w):
    x32 = x.astype(jnp.float32)
    y = x32 * lax.rsqrt(jnp.mean(x32 * x32, axis=-1, keepdims=True) + EPS)
    return (y * w.astype(jnp.float32)).astype(x.dtype)


def rope_tables(positions):
    inv_freq = ROPE_THETA ** (-jnp.arange(0, DA_HEAD_DIM, 2, dtype=jnp.float32) / DA_HEAD_DIM)
    ang = positions.astype(jnp.float32)[..., None] * inv_freq
    ang = jnp.concatenate([ang, ang], axis=-1)[:, None]
    return jnp.cos(ang), jnp.sin(ang)


def apply_rope(t, cos, sin):
    t1, t2 = jnp.split(t, 2, axis=-1)
    rot = jnp.concatenate([-t2, t1], axis=-1)
    return (t * cos + rot * sin).astype(t.dtype)


def diff_attention_mixer(h, cos, sin, w_in, lq1, lk1, lq2, lk2, subln_w, w_out, lambda_init):
    B, S, _ = h.shape
    H, d = DA_HEADS, DA_HEAD_DIM
    proj = h @ w_in
    q, k, v, z = jnp.split(proj, 4, axis=-1)
    q = q.reshape(B, S, 2 * H, d).transpose(0, 2, 1, 3)
    k = k.reshape(B, S, 2 * H, d).transpose(0, 2, 1, 3)
    v = v.reshape(B, S, H, DA_V_DIM).transpose(0, 2, 1, 3)
    q = apply_rope(q, cos, sin) * (d ** -0.5)
    k = apply_rope(k, cos, sin)
    q = q.reshape(B, H, 2, S, d)
    k = k.reshape(B, H, 2, S, d)
    lam = (jnp.exp(jnp.sum(lq1.astype(jnp.float32) * lk1.astype(jnp.float32)))
           - jnp.exp(jnp.sum(lq2.astype(jnp.float32) * lk2.astype(jnp.float32)))
           + lambda_init)
    nb = S // Q_BLOCK
    qb = q.reshape(B, H, 2, nb, Q_BLOCK, d).transpose(3, 0, 1, 2, 4, 5)
    k_pos = jnp.arange(S)
    neg = jnp.finfo(jnp.float32).min

    def block(args):
        q_blk, i = args
        s = jnp.einsum('bhcqd,bhckd->bhcqk', q_blk, k).astype(jnp.float32)
        q_pos = i * Q_BLOCK + jnp.arange(Q_BLOCK)
        mask = k_pos[None, :] <= q_pos[:, None]
        p = jax.nn.softmax(jnp.where(mask, s, neg), axis=-1)
        a = p[:, :, 0] - lam * p[:, :, 1]
        return jnp.einsum('bhqk,bhkv->bhqv', a.astype(v.dtype), v)

    o = lax.map(block, (qb, jnp.arange(nb)))
    o = o.transpose(1, 0, 3, 2, 4).reshape(B, S, H, DA_V_DIM)
    o = rmsnorm(o, subln_w) * (1.0 - lambda_init)
    o = o.reshape(B, S, D_INNER) * jax.nn.silu(z)
    return (o @ w_out).astype(h.dtype)


def gla_mixer(h, w_in, w_gate_up, b_gate, norm_w, w_out):
    B, S, _ = h.shape
    H, C = GLA_HEADS, GLA_CHUNK
    N = S // C
    proj = h @ w_in
    q, k, v, z, g_low = jnp.split(
        proj, [GLA_DK, 2 * GLA_DK, 2 * GLA_DK + D_INNER, 2 * GLA_DK + 2 * D_INNER], axis=-1)
    log_a = jax.nn.log_sigmoid((g_low @ w_gate_up + b_gate).astype(jnp.float32)) / GLA_GATE_TAU

    def heads(t, dh):
        return t.reshape(B, N, C, H, dh).transpose(0, 3, 1, 2, 4)

    q = heads(q, GLA_HEAD_K) * (GLA_HEAD_K ** -0.5)
    k = heads(k, GLA_HEAD_K)
    v = heads(v, GLA_HEAD_V)
    b = jnp.cumsum(heads(log_a, GLA_HEAD_K), axis=3)
    b_last = b[:, :, :, -1:, :]
    q_dec = q * jnp.exp(b)
    k_inv = k * jnp.exp(-b)
    k_end = k * jnp.exp(b_last - b)
    tril = jnp.tril(jnp.ones((C, C), dtype=bool))
    attn = jnp.where(tril, jnp.einsum('bhnid,bhnjd->bhnij', q_dec, k_inv), 0.0)
    o_intra = jnp.einsum('bhnij,bhnjv->bhniv', attn, v)

    def step(state, inp):
        q_c, k_c, v_c, dec_c = inp
        o_c = jnp.einsum('bhcd,bhdv->bhcv', q_c, state)
        state = state * dec_c[..., None] + jnp.einsum('bhcd,bhcv->bhdv', k_c, v_c)
        return state, o_c

    xs = (jnp.moveaxis(q_dec, 2, 0), jnp.moveaxis(k_end, 2, 0),
          jnp.moveaxis(v, 2, 0), jnp.moveaxis(jnp.exp(b_last[:, :, :, 0, :]), 2, 0))
    state0 = jnp.zeros((B, H, GLA_HEAD_K, GLA_HEAD_V), jnp.float32)
    _, o_inter = lax.scan(step, state0, xs)
    o = (o_intra + jnp.moveaxis(o_inter, 0, 2)).astype(h.dtype)
    o = o.transpose(0, 2, 3, 1, 4)
    o = rmsnorm(o, norm_w).reshape(B, S, D_INNER) * jax.nn.silu(z)
    return (o @ w_out).astype(h.dtype)


def setup_inputs(seed: int = 0) -> dict:
    key = jax.random.key(seed)
    ks = jax.random.split(key, 20)
    nrm = jax.random.normal
    f32 = jnp.float32
    x = nrm(ks[0], (BATCH, SEQ, D_MODEL), f32)
    c = nrm(ks[1], (BATCH, D_MODEL), f32)
    offset = jax.random.randint(ks[2], (BATCH, 1), 0, 1024, dtype=jnp.int32)
    positions = offset + jnp.arange(SEQ, dtype=jnp.int32)[None, :]
    ada_w = nrm(ks[3], (DEPTH, D_MODEL, 3 * D_MODEL), f32) * (ADA_STD * D_MODEL ** -0.5)
    ada_b = nrm(ks[4], (DEPTH, 3 * D_MODEL), f32) * 0.02
    norm_g = 1.0 + 0.02 * nrm(ks[5], (DEPTH, D_MODEL), f32)
    da_w_in = nrm(ks[6], (N_DIFF, D_MODEL, 4 * D_INNER), f32) * D_MODEL ** -0.5
    da_lam_q1 = nrm(ks[7], (N_DIFF, DA_HEAD_DIM), f32) * LAMBDA_STD
    da_lam_k1 = nrm(ks[8], (N_DIFF, DA_HEAD_DIM), f32) * LAMBDA_STD
    da_lam_q2 = nrm(ks[9], (N_DIFF, DA_HEAD_DIM), f32) * LAMBDA_STD
    da_lam_k2 = nrm(ks[10], (N_DIFF, DA_HEAD_DIM), f32) * LAMBDA_STD
    da_subln_w = 1.0 + 0.02 * nrm(ks[11], (N_DIFF, DA_V_DIM), f32)
    da_w_out = nrm(ks[12], (N_DIFF, D_INNER, D_MODEL), f32) * D_INNER ** -0.5
    gla_w_in = nrm(ks[13], (N_GLA, D_MODEL, GLA_IN), f32) * D_MODEL ** -0.5
    gla_w_gate_up = nrm(ks[14], (N_GLA, GLA_GATE_RANK, GLA_DK), f32) * GLA_GATE_RANK ** -0.5
    gla_b_gate = nrm(ks[15], (N_GLA, GLA_DK), f32) * 0.1
    gla_norm_w = 1.0 + 0.02 * nrm(ks[16], (N_GLA, GLA_HEAD_V), f32)
    gla_w_out = nrm(ks[17], (N_GLA, D_INNER, D_MODEL), f32) * D_INNER ** -0.5
    final_g = 1.0 + 0.02 * nrm(ks[18], (D_MODEL,), f32)
    return {"x": x, "c": c, "positions": positions, "ada_w": ada_w, "ada_b": ada_b,
            "norm_g": norm_g, "da_w_in": da_w_in, "da_lam_q1": da_lam_q1,
            "da_lam_k1": da_lam_k1, "da_lam_q2": da_lam_q2, "da_lam_k2": da_lam_k2,
            "da_subln_w": da_subln_w, "da_w_out": da_w_out, "gla_w_in": gla_w_in,
            "gla_w_gate_up": gla_w_gate_up, "gla_b_gate": gla_b_gate,
            "gla_norm_w": gla_norm_w, "gla_w_out": gla_w_out, "final_g": final_g}


def reference(x, c, positions, ada_w, ada_b, norm_g, da_w_in, da_lam_q1, da_lam_k1,
              da_lam_q2, da_lam_k2, da_subln_w, da_w_out, gla_w_in, gla_w_gate_up,
              gla_b_gate, gla_norm_w, gla_w_out, final_g):
    cos, sin = rope_tables(positions)
    for i in range(DEPTH):
        mod = c @ ada_w[i] + ada_b[i]
        shift, scale, gate = jnp.split(mod, 3, axis=-1)
        h = rmsnorm(x, norm_g[i]) * (1.0 + scale[:, None, :]) + shift[:, None, :]
        j = i // N_MIXERS
        if i % N_MIXERS == 0:
            lambda_init = 0.8 - 0.6 * math.exp(-0.3 * i)
            out = diff_attention_mixer(h, cos, sin, da_w_in[j], da_lam_q1[j], da_lam_k1[j],
                                       da_lam_q2[j], da_lam_k2[j], da_subln_w[j],
                                       da_w_out[j], lambda_init)
        else:
            out = gla_mixer(h, gla_w_in[j], gla_w_gate_up[j], gla_b_gate[j],
                            gla_norm_w[j], gla_w_out[j])
        x = x + gate[:, None, :] * out
    return rmsnorm(x, final_g)
```

```cpp
#include <hip/hip_runtime.h>
#include <hip/hip_cooperative_groups.h>
#include <cstdio>
#include <cstdint>
namespace pg8 {
#define PG8_LAS __attribute__((address_space(3)))
typedef unsigned short bf16_t;
typedef short bf16x8 __attribute__((ext_vector_type(8)));
typedef float f32x4 __attribute__((ext_vector_type(4)));
typedef unsigned u32x4 __attribute__((ext_vector_type(4)));
constexpr int BM = 256, BK = 64, HALF = 128, HTB = HALF * BK * 2  , STAGE_BYTES = 8 * HTB, NXCD = 8, WGM = 8;

__host__ __device__ __forceinline__ int lds_byte(int r, int c) { const int st = (r >> 4) * 2 + (c >> 5), rr = r & 15, cc = c & 31, ob = rr * 64 + cc * 2; return st * 1024 + (ob ^ (((ob >> 9) & 1) << 5)); }
__host__ __device__ __forceinline__ void stage_rc(int b, int& R, int& C) { const int st = b / 1024, sb = b % 1024, swz = sb ^ (((sb >> 9) & 1) << 5); R = (st >> 1) * 16 + swz / 64; C = (st & 1) * 32 + (swz % 64) / 2; }
__host__ __device__ __forceinline__ int perm32(int rho) { const int n = rho >> 4, i = rho & 15; return 8 * (i >> 2) + 4 * n + (i & 3); }

struct Unit { int pm, pn; };
struct Gemm { const bf16_t* A; const bf16_t* Bt; int M, N, K; };

struct StaticOrder {
    int nM, nN, nwg, G, c;
    __host__ __device__ void init(int M, int N, int G_, int c_) { nM = M / BM; nN = N / BM; nwg = nM * nN; G = G_; c = c_; }
    __host__ __device__ bool next(int i, Unit& u) const {
        const long L = (long)i * G + c; if (L >= nwg) return false;
        int wgid = (int)L; { const int q = nwg / NXCD, r = nwg % NXCD, xcd = wgid % NXCD, off = wgid / NXCD; wgid = (xcd < r ? xcd * (q + 1) : r * (q + 1) + (xcd - r) * q) + off; }
        const int nig = WGM * nN, gid = wgid / nig, fm = gid * WGM, gsz = (nM - fm) < WGM ? (nM - fm) : WGM;
        u.pm = fm + ((wgid % nig) % gsz); u.pn = (wgid % nig) / gsz; return true;
    }
    __device__ __forceinline__ void a_ready(const Unit&) const {}
    __device__ __forceinline__ void done(const Unit&) const {}
};

__device__ __forceinline__ unsigned cvt_pk_bf16(float lo, float hi) { unsigned r; asm volatile("v_cvt_pk_bf16_f32 %0, %1, %2" : "=v"(r) : "v"(lo), "v"(hi)); return r; }
typedef float f32x2 __attribute__((ext_vector_type(2)));
__device__ __forceinline__ f32x2 gelu_pk(f32x2 v) {
    const f32x2 av = __builtin_elementwise_abs(v), d = av * 0.2316418882f + 1.0f;
    f32x2 t; t.x = __builtin_amdgcn_rcpf(d.x); t.y = __builtin_amdgcn_rcpf(d.y);
    f32x2 q = t * 0.5307027145f + (-0.7265760135f); q = q * t + 0.7107068705f; q = q * t + (-0.142248368f); q = q * t + 0.127414796f; q = q * t;
    const f32x2 s = (v * v) * (-0.72134752044f);
    f32x2 e; e.x = __builtin_amdgcn_exp2f(s.x); e.y = __builtin_amdgcn_exp2f(s.y);
    const f32x2 m = v * (q * e), r = v - m;
    f32x2 o; o.x = v.x < 0.f ? m.x : r.x; o.y = v.y < 0.f ? m.y : r.y; return o;
}

template <int ACT  > struct EpiBf16 {
    static constexpr bool PERM = true, AFTER_DRAIN = false; static_assert(ACT == 0 || ACT == 1, "EpiBf16: ACT is 0 (none) or 1 (gelu_pk)");
    bf16_t* O; int ldc; const float* bias; int split_cols; size_t split_stride; float scale0;
    __device__ __forceinline__ void operator()(const f32x4 (&acc)[2][2][4][2], const Unit& u, int wr, int wc, int fr, int fq) const {
        const int row0 = u.pm * BM + wr * 64 + fr; int colt = u.pn * BM; bf16_t* base = O;
        float sc = 1.f; if (split_cols) { const int t = colt / split_cols; base += (size_t)t * split_stride; colt -= t * split_cols; if (t == 0) sc = scale0; }
        const int col0 = colt + wc * 32 + 8 * fq, bcol0 = u.pn * BM + wc * 32 + 8 * fq;
        f32x4 bv[2][2];
#pragma unroll
        for (int bj = 0; bj < 2; ++bj)
#pragma unroll
            for (int n = 0; n < 2; ++n) bv[bj][n] = bias ? *(const f32x4*)(bias + bcol0 + bj * HALF + 4 * n) : (f32x4){0.f, 0.f, 0.f, 0.f};
#pragma unroll
        for (int ai = 0; ai < 2; ++ai)
#pragma unroll
            for (int m = 0; m < 4; ++m) { bf16_t* rowp = base + (size_t)(row0 + ai * HALF + m * 16) * ldc + col0;
#pragma unroll
                for (int bj = 0; bj < 2; ++bj) { f32x4 v0 = acc[ai][bj][m][0] + bv[bj][0], v1 = acc[ai][bj][m][1] + bv[bj][1];
                    if (ACT == 1) { f32x2 a = gelu_pk((f32x2){v0[0], v0[1]}), b = gelu_pk((f32x2){v0[2], v0[3]}), c = gelu_pk((f32x2){v1[0], v1[1]}), d = gelu_pk((f32x2){v1[2], v1[3]});
                        v0 = (f32x4){a.x, a.y, b.x, b.y}; v1 = (f32x4){c.x, c.y, d.x, d.y}; }
                    v0 = v0 * sc; v1 = v1 * sc; u32x4 w; w.x = cvt_pk_bf16(v0[0], v0[1]); w.y = cvt_pk_bf16(v0[2], v0[3]); w.z = cvt_pk_bf16(v1[0], v1[1]); w.w = cvt_pk_bf16(v1[2], v1[3]);
                    *(u32x4*)(rowp + bj * HALF) = w; } }
    }
};


template <class Epi, class Sched, bool ALIGN_EPI = false, bool SP2 = false>
__device__ __forceinline__ void gemm_phase(PG8_LAS unsigned char* lds, const Gemm g, const Sched& S, const Epi& E) {
    int tid_ = threadIdx.x; asm volatile("" : "+v"(tid_)); const int tid = tid_, wid = __builtin_amdgcn_readfirstlane(tid >> 6), lane = tid & 63, wr = wid >> 2, wc = wid & 3, fr = lane & 15, fq = lane >> 4;
    const int K = g.K, nt = K / BK;
    unsigned voffA[2], voffB[2];
#pragma unroll
    for (int i = 0; i < 2; ++i) { int R, C; stage_rc(tid * 16 + i * 8192, R, C); const int Rb = Epi::PERM ? ((R & ~31) + perm32(R & 31)) : R;
        voffA[i] = (unsigned)(R * K + C) * 2u; voffB[i] = (unsigned)(Rb * K + C) * 2u; }
    const size_t kstep = (size_t)(BK * 2);
    const size_t hstep = (size_t)HALF * K * 2;
    const size_t tstep = 2 * hstep;
    const unsigned ldsw = (unsigned)wid * 1024u;
    const int aoff = lds_byte(wr * 64 + fr, fq * 8), boff = lds_byte(wc * 32 + fr, fq * 8);
#define PG8_SA(b, h) (((b) * 2 + (h)) * HTB)
#define PG8_SB(b, h) ((4 + (b) * 2 + (h)) * HTB)
#define PG8_STAGE(bufoff, gbase, voff) do { _Pragma("unroll") for (int _i = 0; _i < 2; ++_i) \
        __builtin_amdgcn_global_load_lds((const unsigned*)((const char*)(gbase) + (voff)[_i]), (PG8_LAS unsigned*)(lds + (bufoff) + ldsw + _i * 8192), 16, 0, 0); } while (0)
#define PG8_LDA(dst, b, h) do { _Pragma("unroll") for (int m = 0; m < 4; ++m) _Pragma("unroll") for (int k = 0; k < 2; ++k) dst[m][k] = *(const PG8_LAS bf16x8*)(lds + PG8_SA(b, h) + aoff + m * 2048 + k * 1024); } while (0)
#define PG8_LDB(dst, b, h) do { _Pragma("unroll") for (int n = 0; n < 2; ++n) _Pragma("unroll") for (int k = 0; k < 2; ++k) dst[n][k] = *(const PG8_LAS bf16x8*)(lds + PG8_SB(b, h) + boff + n * 2048 + k * 1024); } while (0)
#define PG8_MMA(ai, bj, At, Bt) do { __builtin_amdgcn_s_setprio(1); _Pragma("unroll") for (int m = 0; m < 4; ++m) _Pragma("unroll") for (int n = 0; n < 2; ++n) _Pragma("unroll") for (int k = 0; k < 2; ++k) \
        acc[ai][bj][m][n] = __builtin_amdgcn_mfma_f32_16x16x32_bf16(Bt[n][k], At[m][k], acc[ai][bj][m][n], 0, 0, 0); __builtin_amdgcn_s_setprio(0); } while (0)
#define PG8_WAIT_V(n) asm volatile("s_waitcnt vmcnt(" #n ")" ::: "memory")
#define PG8_WAIT_L(n) asm volatile("s_waitcnt lgkmcnt(" #n ")" ::: "memory")
#define PG8_BAR __builtin_amdgcn_s_barrier()
#define PG8_SCHED __builtin_amdgcn_sched_barrier(0)
    Unit cur, nxt; int ui = 0;
    if (!S.next(0, cur)) return;
    f32x4 acc[2][2][4][2];
#pragma unroll
    for (int a = 0; a < 2; ++a)
#pragma unroll
        for (int b = 0; b < 2; ++b)
#pragma unroll
            for (int m = 0; m < 4; ++m)
#pragma unroll
                for (int n = 0; n < 2; ++n) acc[a][b][m][n] = (f32x4){0.f, 0.f, 0.f, 0.f};
    bf16x8 At[4][2], B0[2][2], B1[2][2];
    const char* cA = (const char*)g.A + (size_t)cur.pm * tstep; const char* cB = (const char*)g.Bt + (size_t)cur.pn * tstep;
    S.a_ready(cur);
    if constexpr (SP2) {
        PG8_STAGE(PG8_SB(0, 0), cB, voffB); PG8_STAGE(PG8_SB(0, 1), cB + hstep, voffB); PG8_STAGE(PG8_SA(0, 0), cA, voffA); PG8_STAGE(PG8_SA(0, 1), cA + hstep, voffA);
        if (wr == 1) PG8_BAR;
        PG8_WAIT_V(2); PG8_BAR;
        PG8_STAGE(PG8_SB(1, 0), cB + kstep, voffB); PG8_STAGE(PG8_SA(1, 0), cA + kstep, voffA); PG8_STAGE(PG8_SB(1, 1), cB + hstep + kstep, voffB);
        PG8_WAIT_V(6); PG8_BAR;
    } else {
        PG8_STAGE(PG8_SB(0, 0), cB, voffB); PG8_STAGE(PG8_SA(0, 0), cA, voffA); PG8_STAGE(PG8_SB(0, 1), cB + hstep, voffB); PG8_STAGE(PG8_SA(0, 1), cA + hstep, voffA);
        if (wr == 1) PG8_BAR;
        PG8_WAIT_V(4); PG8_BAR;
        PG8_STAGE(PG8_SB(1, 0), cB + kstep, voffB); PG8_STAGE(PG8_SA(1, 0), cA + kstep, voffA); PG8_STAGE(PG8_SB(1, 1), cB + hstep + kstep, voffB);
        PG8_WAIT_V(6); PG8_BAR;
    }
    for (;;) {
        const bool has_next = S.next(ui + 1, nxt);
        const char* nA = has_next ? (const char*)g.A + (size_t)nxt.pm * tstep : cA; const char* nB = has_next ? (const char*)g.Bt + (size_t)nxt.pn * tstep : cB;
        for (int t = 0; t < nt; t += 2) {
            const bool last = (t == nt - 2);
            const char* a1 = cA + (size_t)(t + 1) * kstep;
            const char* a2 = last ? nA : cA + (size_t)(t + 2) * kstep; const char* b2 = last ? nB : cB + (size_t)(t + 2) * kstep;
            const char* a3 = a2 + kstep; const char* b3 = b2 + kstep;
            if (last && has_next) S.a_ready(nxt);
            if constexpr (SP2) {
            PG8_LDB(B0, 0, 0); PG8_LDB(B1, 0, 1); PG8_SCHED; PG8_LDA(At, 0, 0); PG8_STAGE(PG8_SA(1, 1), a1 + hstep, voffA);
            PG8_WAIT_V(8); PG8_WAIT_L(0); PG8_BAR; PG8_MMA(0, 0, At, B0); PG8_MMA(0, 1, At, B1); PG8_BAR; PG8_SCHED;
            PG8_LDA(At, 0, 1); PG8_STAGE(PG8_SB(0, 0), b2, voffB); PG8_STAGE(PG8_SB(0, 1), b2 + hstep, voffB); PG8_STAGE(PG8_SA(0, 0), a2, voffA);
            PG8_WAIT_V(8); PG8_WAIT_L(0); PG8_BAR; PG8_MMA(1, 0, At, B0); PG8_MMA(1, 1, At, B1); PG8_BAR; PG8_SCHED;
            PG8_LDB(B0, 1, 0); PG8_LDB(B1, 1, 1); PG8_SCHED; PG8_LDA(At, 1, 0); PG8_STAGE(PG8_SA(0, 1), a2 + hstep, voffA);
            PG8_WAIT_V(8); PG8_WAIT_L(0); PG8_BAR; PG8_MMA(0, 0, At, B0); PG8_MMA(0, 1, At, B1); PG8_BAR; PG8_SCHED;
            PG8_LDA(At, 1, 1); PG8_STAGE(PG8_SB(1, 0), b3, voffB); PG8_STAGE(PG8_SB(1, 1), b3 + hstep, voffB); PG8_STAGE(PG8_SA(1, 0), a3, voffA);
            PG8_WAIT_V(8); PG8_WAIT_L(0); PG8_BAR; PG8_MMA(1, 0, At, B0); PG8_MMA(1, 1, At, B1); PG8_BAR; PG8_SCHED;
            } else {
            PG8_LDB(B0, 0, 0); PG8_SCHED; PG8_LDA(At, 0, 0); PG8_STAGE(PG8_SA(1, 1), a1 + hstep, voffA);
            PG8_WAIT_L(8); PG8_BAR; PG8_WAIT_L(0); PG8_MMA(0, 0, At, B0); PG8_BAR; PG8_SCHED;
            PG8_LDB(B1, 0, 1); PG8_STAGE(PG8_SB(0, 0), b2, voffB);
            PG8_BAR; PG8_WAIT_L(0); PG8_MMA(0, 1, At, B1); PG8_BAR;
            PG8_LDA(At, 0, 1); PG8_STAGE(PG8_SA(0, 0), a2, voffA);
            PG8_BAR; PG8_WAIT_L(0); PG8_MMA(1, 0, At, B0); PG8_BAR; PG8_SCHED;
            PG8_STAGE(PG8_SB(0, 1), b2 + hstep, voffB);
            PG8_WAIT_V(6); PG8_BAR; PG8_MMA(1, 1, At, B1); PG8_BAR;
            PG8_LDB(B0, 1, 0); PG8_SCHED; PG8_LDA(At, 1, 0); PG8_STAGE(PG8_SA(0, 1), a2 + hstep, voffA);
            PG8_WAIT_L(8); PG8_BAR; PG8_WAIT_L(0); PG8_MMA(0, 0, At, B0); PG8_BAR; PG8_SCHED;
            PG8_LDB(B1, 1, 1); PG8_STAGE(PG8_SB(1, 0), b3, voffB);
            PG8_BAR; PG8_WAIT_L(0); PG8_MMA(0, 1, At, B1); PG8_BAR;
            PG8_LDA(At, 1, 1); PG8_STAGE(PG8_SA(1, 0), a3, voffA);
            PG8_BAR; PG8_WAIT_L(0); PG8_MMA(1, 0, At, B0); PG8_BAR; PG8_SCHED;
            PG8_STAGE(PG8_SB(1, 1), b3 + hstep, voffB);
            PG8_WAIT_V(6); PG8_BAR; PG8_MMA(1, 1, At, B1); PG8_BAR;
            }
        }
        if constexpr (ALIGN_EPI) { if (wr == 0) PG8_BAR; }
        if constexpr (!Epi::AFTER_DRAIN) { E(acc, cur, wr, wc, fr, fq); S.done(cur); }
        if (!has_next) break;
#pragma unroll
        for (int a = 0; a < 2; ++a)
#pragma unroll
            for (int b = 0; b < 2; ++b)
#pragma unroll
                for (int m = 0; m < 4; ++m)
#pragma unroll
                    for (int n = 0; n < 2; ++n) acc[a][b][m][n] = (f32x4){0.f, 0.f, 0.f, 0.f};
        cur = nxt; cA = nA; cB = nB; ++ui;
        if constexpr (ALIGN_EPI) { if (wr == 1) PG8_BAR; }
    }
    PG8_WAIT_V(0);
    if constexpr (!ALIGN_EPI) { if (wr == 0) PG8_BAR; }
    PG8_BAR;
    if constexpr (Epi::AFTER_DRAIN) { E.fused(acc, cur, wr, wc, fr, fq, lds, wid, lane); S.done(cur); }
#undef PG8_SA
#undef PG8_SB
#undef PG8_STAGE
#undef PG8_LDA
#undef PG8_LDB
#undef PG8_MMA
#undef PG8_WAIT_V
#undef PG8_WAIT_L
#undef PG8_BAR
#undef PG8_SCHED
}
}
#include <hip/hip_bf16.h>
#include <cmath>
namespace attn_body {
using bf16=__hip_bfloat16;
using bf16x8=__attribute__((ext_vector_type(8)))short;
using s16x4=__attribute__((ext_vector_type(4)))short;
using f32x16=__attribute__((ext_vector_type(16)))float;
using u32x4=__attribute__((ext_vector_type(4)))unsigned;
constexpr int D=64,QP=2048,KP=2048,VP=2048,OP=64;
constexpr int NW=8,QBLK=32,QB=QBLK*NW,KVBLK=64;
constexpr int ATTN_UNIT_ROWS=QB;
__device__ __forceinline__ int crow(int r,int hi){return (r&3)+8*(r>>2)+4*hi;}
#define SBAR() __builtin_amdgcn_sched_barrier(0)
__device__ __forceinline__ void cmask(f32x16&p0,f32x16&p1,int jb,int qrel,int hi){
  const float NEG=-INFINITY; int kb=64*jb+4*hi;
  #pragma unroll
  for(int r=0;r<16;++r){int kv=kb+(r&3)+8*(r>>2); if(kv>qrel)p0[r]=NEG; if(kv+32>qrel)p1[r]=NEG;}
}

constexpr int NSLOT=3, SLOTB=8192;
constexpr int LDS_K=0, LDS_V=NSLOT*SLOTB, LDS_WS=2*NSLOT*SLOTB, LDS_OST=LDS_WS+NW*64*4, LDS_BYTES=LDS_OST+NW*4096;
constexpr float C2=0.125f*1.4426950408889634f;
__device__ __forceinline__ void glds16(const void*gsrc,unsigned lds_dst){unsigned keep;
  asm volatile("s_mov_b32 %0, m0\n\ts_mov_b32 m0, %2\n\ts_nop 0\n\tglobal_load_lds_dwordx4 %1, off\n\ts_mov_b32 m0, %0":"=&s"(keep):"v"(gsrc),"s"(lds_dst):"memory");}
__device__ __forceinline__ float max3f(float a,float b,float c){float r;asm("v_max3_f32 %0, %1, %2, %3":"=v"(r):"v"(a),"v"(b),"v"(c));return r;}
__device__ __forceinline__ float max2f(float a,float b){float r;asm("v_max_f32_e32 %0, %1, %2":"=v"(r):"v"(a),"v"(b));return r;}
__device__ __forceinline__ float fadd_s(float a,float b){float r;asm("v_add_f32_e32 %0, %1, %2":"=v"(r):"v"(a),"v"(b));return r;}
__device__ __forceinline__ float fsub_s(float a,float b){float r;asm("v_sub_f32_e32 %0, %1, %2":"=v"(r):"v"(a),"v"(b));return r;}
typedef float f32x2_t __attribute__((ext_vector_type(2))); typedef __bf16 bf16x2_t __attribute__((ext_vector_type(2)));
__device__ __forceinline__ unsigned cvtpk_s(float lo,float hi){f32x2_t v={lo,hi};bf16x2_t b=__builtin_convertvector(v,bf16x2_t);return __builtin_bit_cast(unsigned,b);}
#define WAIT_BAR(N) asm volatile("s_waitcnt vmcnt(" #N ") lgkmcnt(0)\n\ts_barrier":::"memory")

__device__ __forceinline__ void qkt(f32x16&p0,f32x16&p1,const char*Kslot,const bf16x8*qr,const f32x16&negm,int r32,int hi){
  const char*kb=Kslot+hi*1024+r32*16;
  #pragma unroll
  for(int d0=0;d0<4;++d0){
    const bf16x8 b0=*reinterpret_cast<const bf16x8*>(kb+d0*2048);
    const bf16x8 b1=*reinterpret_cast<const bf16x8*>(kb+d0*2048+512);
    if(d0==0){p0=__builtin_amdgcn_mfma_f32_32x32x16_bf16(b0,qr[0],negm,0,0,0);p1=__builtin_amdgcn_mfma_f32_32x32x16_bf16(b1,qr[0],negm,0,0,0);}
    else{p0=__builtin_amdgcn_mfma_f32_32x32x16_bf16(b0,qr[d0],p0,0,0,0);p1=__builtin_amdgcn_mfma_f32_32x32x16_bf16(b1,qr[d0],p1,0,0,0);}}
}
typedef __attribute__((address_space(3))) const char* lds_cptr;
typedef short v4i16_t __attribute__((ext_vector_type(4)));
__device__ __forceinline__ void kload8(bf16x8*kf,lds_cptr kp){
  kf[0]=*(const __attribute__((address_space(3))) bf16x8*)(kp);      kf[1]=*(const __attribute__((address_space(3))) bf16x8*)(kp+512);
  kf[2]=*(const __attribute__((address_space(3))) bf16x8*)(kp+2048); kf[3]=*(const __attribute__((address_space(3))) bf16x8*)(kp+2560);
  kf[4]=*(const __attribute__((address_space(3))) bf16x8*)(kp+4096); kf[5]=*(const __attribute__((address_space(3))) bf16x8*)(kp+4608);
  kf[6]=*(const __attribute__((address_space(3))) bf16x8*)(kp+6144); kf[7]=*(const __attribute__((address_space(3))) bf16x8*)(kp+6656);
}
__device__ __forceinline__ void kload2(bf16x8*kf,lds_cptr kp,int j){ kf[2*j]=*(const __attribute__((address_space(3))) bf16x8*)(kp+j*2048); kf[2*j+1]=*(const __attribute__((address_space(3))) bf16x8*)(kp+j*2048+512); }
__device__ __forceinline__ s16x4 vtr(lds_cptr p){ return __builtin_bit_cast(s16x4,__builtin_amdgcn_ds_read_tr16_b64_v4i16((__attribute__((address_space(3))) v4i16_t*)p)); }
__device__ __forceinline__ float rowmax(const f32x16&p0,const f32x16&p1){
  float a=max3f(p0[0],p0[1],p1[0]),b=max3f(p0[2],p0[3],p1[1]);a=max3f(a,p1[2],p1[3]);
  #pragma unroll
  for(int r=4;r<16;r+=4){a=max3f(a,p0[r],p0[r+1]);b=max3f(b,p0[r+2],p0[r+3]);a=max3f(a,p1[r],p1[r+1]);b=max3f(b,p1[r+2],p1[r+3]);}
  const float m=max2f(a,b);
  auto rr=__builtin_amdgcn_permlane32_swap(__float_as_uint(m),__float_as_uint(m),false,false);
  return max2f(__uint_as_float(rr[0]),__uint_as_float(rr[1]));
}
__device__ __forceinline__ void pv(f32x16*o,int vb,bf16x8 pa0,bf16x8 pa1,bf16x8 pa2,bf16x8 pa3){
  #pragma unroll
  for(int d0=0;d0<2;++d0){s16x4 lo[4],hi[4];
    #pragma unroll
    for(int ks=0;ks<4;++ks){
      asm volatile("ds_read_b64_tr_b16 %0,%1 offset:%c2":"=&v"(lo[ks]):"v"(vb),"i"(d0*4096+ks*1024):"memory");
      asm volatile("ds_read_b64_tr_b16 %0,%1 offset:%c2":"=&v"(hi[ks]):"v"(vb),"i"(d0*4096+ks*1024+512):"memory");}
    asm volatile("s_waitcnt lgkmcnt(0)":::"memory");SBAR();
    #define PK(k) (bf16x8){lo[k][0],lo[k][1],lo[k][2],lo[k][3],hi[k][0],hi[k][1],hi[k][2],hi[k][3]}
    o[d0]=__builtin_amdgcn_mfma_f32_32x32x16_bf16(pa0,PK(0),o[d0],0,0,0);
    o[d0]=__builtin_amdgcn_mfma_f32_32x32x16_bf16(pa1,PK(1),o[d0],0,0,0);
    o[d0]=__builtin_amdgcn_mfma_f32_32x32x16_bf16(pa2,PK(2),o[d0],0,0,0);
    o[d0]=__builtin_amdgcn_mfma_f32_32x32x16_bf16(pa3,PK(3),o[d0],0,0,0);
    #undef PK
  }
}

#ifndef ATTN_STORE16
#define ATTN_STORE16(p,v) (*(u32x4*)(p)=(v))
#endif
template<int THRL> __device__ __forceinline__ void attn_unit(int qb,const bf16*Qu,const bf16*__restrict__ Kh,const bf16*__restrict__ Vh,bf16*Ou,char*shm){
  int tid_=threadIdx.x; asm volatile("":"+v"(tid_)); const int tid=tid_,lane=tid&63,r32=lane&31,hi=lane>>5; const int wid=__builtin_amdgcn_readfirstlane(tid>>6);
  const int q0=qb*QB;
  const bf16*Qw=Qu+(long)(wid*QBLK)*QP;
  const unsigned lds0=(unsigned)(uintptr_t)shm;
  float*wsf=(float*)(shm+LDS_WS)+wid*64;
  const bf16*ksrc=Kh+(long)lane*KP+wid*8;
  const bf16*vsrc=Vh+(long)(16*(wid&3)+(lane>>2))*VP+(wid>>2)*32+(lane&3)*8;
  const unsigned kdst=lds0+LDS_K+wid*1024, vdst=lds0+LDS_V+wid*1024;
  #define DMA_K(t,slot) glds16(ksrc+(long)(t)*KVBLK*KP,(unsigned)__builtin_amdgcn_readfirstlane(kdst+(slot)))
  #define DMA_V(t,slot) glds16(vsrc+(long)(t)*KVBLK*VP,(unsigned)__builtin_amdgcn_readfirstlane(vdst+(slot)))
  const int vb0=(int)(lds0+LDS_V)+((lane>>4)&1)*32+(lane&3)*8+(4*hi+((lane&15)>>2))*64;
  const char*Kbase=shm+LDS_K; bf16x8 kf[8];
  const lds_cptr shm3=(lds_cptr)shm; const lds_cptr kp0=shm3+LDS_K+hi*1024+r32*16; const lds_cptr vp0=shm3+LDS_V+((lane>>4)&1)*32+(lane&3)*8+(4*hi+((lane&15)>>2))*64;
  const int NT=(q0+QB)/KVBLK;
  DMA_K(0,0);DMA_V(0,0);DMA_K(1,SLOTB);
  bf16x8 qr[4];
  #pragma unroll
  for(int d0=0;d0<4;++d0)qr[d0]=*reinterpret_cast<const bf16x8*>(&Qw[(long)r32*QP+d0*16+hi*8]);
  float mhat=0.f,l_reg=0.f;f32x16 o[2];o[0]=f32x16{};o[1]=f32x16{};f32x16 negm=f32x16{};asm volatile("":"+v"(negm));
  const int qrel=wid*QBLK+r32;
  #define CMASK(P0,P1,t) do{int jb_=(t)-(NT-4); if(jb_>=0)cmask(P0,P1,jb_,qrel,hi);}while(0)
  bool resc=false;
  #define START(P0,P1) do{ const float rm=rowmax(P0,P1); resc=false; \
    { const float dl=rm; mhat=fadd_s(mhat,dl); \
      _Pragma("unroll") for(int r=0;r<16;++r){P0[r]=fsub_s(P0[r],dl);P1[r]=fsub_s(P1[r],dl);} \
      _Pragma("unroll") for(int r=0;r<16;++r)negm[r]=-mhat; asm volatile("":"+v"(negm)); } \
    _Pragma("unroll") for(int r=0;r<16;++r)P0[r]=__builtin_amdgcn_exp2f(P0[r]); }while(0)
  #define RESC() do{ if(resc){ asm volatile("s_waitcnt lgkmcnt(0)":::"memory"); \
      _Pragma("unroll") for(int d_=0;d_<2;++d_) _Pragma("unroll") for(int r=0;r<16;++r)o[d_][r]*=wsf[crow(r,hi)]; } }while(0)
  f32x16 pA0,pA1,pB0,pB1;
  int sl_prev=0,sl_cur=0,sl_next=SLOTB;
  #define ROT() do{sl_prev=sl_cur;sl_cur=sl_next;sl_next=(sl_next==(NSLOT-1)*SLOTB)?0:sl_next+SLOTB;}while(0)
  DMA_K(2,2*SLOTB);
  WAIT_BAR(3);
  qkt(pA0,pA1,Kbase,qr,negm,r32,hi);asm volatile("s_nop 15\n\ts_nop 7":"+v"(pA0),"+v"(pA1));CMASK(pA0,pA1,0);
  START(pA0,pA1);
  _Pragma("unroll") for(int r=0;r<16;++r)pA1[r]=__builtin_amdgcn_exp2f(pA1[r]);
  WAIT_BAR(0);
  DMA_K(3,0);DMA_V(1,SLOTB);
  ROT();
  kload8(kf,kp0+sl_cur);
  WAIT_BAR(2);
  s16x4 vlo[8],vhi[8]; u32x4 pw0,pw1,pw2,pw3;
  #define PKW(P,B) cvtpk_s(P[B],P[B+1])
  #define PAF(k) __builtin_bit_cast(bf16x8,pw##k)
  #define VFR(i) (bf16x8){vlo[i][0],vlo[i][1],vlo[i][2],vlo[i][3],vhi[i][0],vhi[i][1],vhi[i][2],vhi[i][3]}
  #define PIN(x) asm volatile("":"+v"(x))
  #define MX3(a,b,c) __builtin_fmaxf(__builtin_fmaxf((a),(b)),(c))
  #define GAPA(MF,A0,A1,A2,A3,W0,W1,PW) do{ MF; sacc+=A0; sacc+=A1; sacc+=A2; sacc+=A3; PIN(sacc); W0; W1; PIN(PW); SBAR(); }while(0)
  #define EX(v) __builtin_amdgcn_exp2f(v)
  #define GAPB(MF,X,B) do{ MF; X[B]=EX(X[B]); X[B+1]=EX(X[B+1]); X[B+2]=EX(X[B+2]); X[B+3]=EX(X[B+3]); PIN(X); SBAR(); }while(0)
  #define VRD(i) do{ vlo[i]=vtr(vp_+(((i)>>2)*4096+((i)&3)*1024)); vhi[i]=vtr(vp_+(((i)>>2)*4096+((i)&3)*1024+512)); }while(0)
  #define KRD(G,j) do{ if(G){ kload2(kf,kp0+sl_next,j); SBAR(); } }while(0)
  #define STEP(C0,C1,P0,P1,t,GK,GV,GL) do{ SBAR(); \
    const lds_cptr vp_=vp0+sl_prev; \
    VRD(0); SBAR(); float sacc=(P0[0]+P0[1]); \
    GAPA(C0=__builtin_amdgcn_mfma_f32_32x32x16_bf16(kf[0],qr[0],negm,0,0,0), P0[2],P0[3],P0[4],P0[5],     pw0[0]=PKW(P0,0), pw0[1]=PKW(P0,2), pw0); \
    VRD(4); SBAR(); GAPA(C1=__builtin_amdgcn_mfma_f32_32x32x16_bf16(kf[1],qr[0],negm,0,0,0), P0[6],P0[7],P0[8],P0[9],     pw0[2]=PKW(P0,4), pw0[3]=PKW(P0,6), pw0); \
    VRD(1); SBAR(); GAPA(C0=__builtin_amdgcn_mfma_f32_32x32x16_bf16(kf[2],qr[1],C0,0,0,0),   P0[10],P0[11],P0[12],P0[13], pw1[0]=PKW(P0,8), pw1[1]=PKW(P0,10), pw1); \
    VRD(5); SBAR(); GAPA(C1=__builtin_amdgcn_mfma_f32_32x32x16_bf16(kf[3],qr[1],C1,0,0,0),   P0[14],P0[15],P1[0],P1[1],   pw1[2]=PKW(P0,12),pw1[3]=PKW(P0,14), pw1); \
    VRD(2); SBAR(); GAPA(C0=__builtin_amdgcn_mfma_f32_32x32x16_bf16(kf[4],qr[2],C0,0,0,0),   P1[2],P1[3],P1[4],P1[5],     pw2[0]=PKW(P1,0), pw2[1]=PKW(P1,2), pw2); \
    VRD(6); SBAR(); GAPA(C1=__builtin_amdgcn_mfma_f32_32x32x16_bf16(kf[5],qr[2],C1,0,0,0),   P1[6],P1[7],P1[8],P1[9],     pw2[2]=PKW(P1,4), pw2[3]=PKW(P1,6), pw2); \
    VRD(3); SBAR(); GAPA(C0=__builtin_amdgcn_mfma_f32_32x32x16_bf16(kf[6],qr[3],C0,0,0,0),   P1[10],P1[11],P1[12],P1[13], pw3[0]=PKW(P1,8), pw3[1]=PKW(P1,10), pw3); \
    VRD(7); SBAR(); GAPA(C1=__builtin_amdgcn_mfma_f32_32x32x16_bf16(kf[7],qr[3],C1,0,0,0),   P1[14],P1[15],0.f,0.f,       pw3[2]=PKW(P1,12),pw3[3]=PKW(P1,14), pw3); \
    l_reg+=sacc; \
    if(GK){DMA_K((t)+3,sl_cur);} if(GV){DMA_V((t)+1,sl_next);} \
    CMASK(C0,C1,t); \
    { float a=MX3(C0[0],C0[1],C1[0]),b=MX3(C0[2],C0[3],C1[1]); a=MX3(a,C1[2],C1[3]); \
      _Pragma("unroll") for(int r=4;r<16;r+=4){a=MX3(a,C0[r],C0[r+1]);b=MX3(b,C0[r+2],C0[r+3]);a=MX3(a,C1[r],C1[r+1]);b=MX3(b,C1[r+2],C1[r+3]);} \
      float rm=__builtin_fmaxf(a,b); { auto rr=__builtin_amdgcn_permlane32_swap(__float_as_uint(rm),__float_as_uint(rm),false,false); rm=__builtin_fmaxf(__uint_as_float(rr[0]),__uint_as_float(rr[1])); } \
      resc=false; \
      if(__builtin_expect(__any(rm>(float)THRL),0)){ const float dl=__builtin_fmaxf(rm,0.f); mhat+=dl; \
        _Pragma("unroll") for(int r=0;r<16;++r){C0[r]-=dl;C1[r]-=dl;} \
        _Pragma("unroll") for(int r=0;r<16;++r)negm[r]=-mhat; asm volatile("":"+v"(negm)); \
        const float f=__builtin_amdgcn_exp2f(-dl); l_reg*=f; if(hi==0)wsf[r32]=f; resc=true; } } \
    SBAR(); \
    GAPB(o[0]=__builtin_amdgcn_mfma_f32_32x32x16_bf16(PAF(0),VFR(0),o[0],0,0,0), C0,0); \
    GAPB(o[1]=__builtin_amdgcn_mfma_f32_32x32x16_bf16(PAF(0),VFR(4),o[1],0,0,0), C0,4); \
    KRD(GL,0); GAPB(o[0]=__builtin_amdgcn_mfma_f32_32x32x16_bf16(PAF(1),VFR(1),o[0],0,0,0), C0,8); \
    KRD(GL,1); GAPB(o[1]=__builtin_amdgcn_mfma_f32_32x32x16_bf16(PAF(1),VFR(5),o[1],0,0,0), C0,12); \
    KRD(GL,2); GAPB(o[0]=__builtin_amdgcn_mfma_f32_32x32x16_bf16(PAF(2),VFR(2),o[0],0,0,0), C1,0); \
    KRD(GL,3); GAPB(o[1]=__builtin_amdgcn_mfma_f32_32x32x16_bf16(PAF(2),VFR(6),o[1],0,0,0), C1,4); \
    GAPB(o[0]=__builtin_amdgcn_mfma_f32_32x32x16_bf16(PAF(3),VFR(3),o[0],0,0,0), C1,8); \
    GAPB(o[1]=__builtin_amdgcn_mfma_f32_32x32x16_bf16(PAF(3),VFR(7),o[1],0,0,0), C1,12); \
    }while(0)
  int t=1;
  #undef CMASK
  #define CMASK(P0,P1,t) do{}while(0)
  for(;t+5<NT;t+=2){
    STEP(pB0,pB1,pA0,pA1,t,true,true,true);     WAIT_BAR(2); RESC(); ROT();
    STEP(pA0,pA1,pB0,pB1,t+1,true,true,true);   WAIT_BAR(2); RESC(); ROT();
  }
  #undef CMASK
  #define CMASK(P0,P1,t) do{int jb_=(t)-(NT-4); if(jb_>=0)cmask(P0,P1,jb_,qrel,hi);}while(0)
  #define ENDW(tt) do{ if((tt)+3<NT){WAIT_BAR(2);} else if((tt)+2<NT){WAIT_BAR(1);} else {WAIT_BAR(0);} }while(0)
  for(;t+1<NT;t+=2){
    STEP(pB0,pB1,pA0,pA1,t,(t+3<NT),(t+1<NT),(t+1<NT));       ENDW(t);   RESC(); ROT();
    STEP(pA0,pA1,pB0,pB1,t+1,(t+4<NT),(t+2<NT),(t+2<NT));     ENDW(t+1); RESC(); ROT();
  }
  STEP(pB0,pB1,pA0,pA1,NT-1,false,false,false); RESC();
  { float sacc=pB0[0]+pB0[1]; _Pragma("unroll") for(int r=2;r<16;++r)sacc+=pB0[r]; _Pragma("unroll") for(int r=0;r<16;++r)sacc+=pB1[r]; l_reg+=sacc;
    pw0=(u32x4){PKW(pB0,0),PKW(pB0,2),PKW(pB0,4),PKW(pB0,6)};pw1=(u32x4){PKW(pB0,8),PKW(pB0,10),PKW(pB0,12),PKW(pB0,14)};pw2=(u32x4){PKW(pB1,0),PKW(pB1,2),PKW(pB1,4),PKW(pB1,6)};pw3=(u32x4){PKW(pB1,8),PKW(pB1,10),PKW(pB1,12),PKW(pB1,14)};
    SBAR(); pv(o,vb0+sl_cur,PAF(0),PAF(1),PAF(2),PAF(3)); }
  #undef PKW
  #undef PAF
  #undef VFR
  #undef PIN
  #undef MX3
  #undef GAPA
  #undef GAPB
  #undef EX
  #undef VRD
  #undef KRD
  #undef STEP
  #undef ENDW
  {auto rr=__builtin_amdgcn_permlane32_swap(__float_as_uint(l_reg),__float_as_uint(l_reg),false,false);l_reg=__uint_as_float(rr[0])+__uint_as_float(rr[1]);}
  if(hi==0)wsf[32+r32]=l_reg;asm volatile("s_waitcnt lgkmcnt(0)":::"memory");
  float rli[16];
  #pragma unroll
  for(int r=0;r<16;++r)rli[r]=__builtin_amdgcn_rcpf(wsf[32+crow(r,hi)]);
  bf16*Ow=Ou+(long)(wid*QBLK)*OP;
  { bf16*stg=(bf16*)(shm+LDS_OST)+wid*2048;
    #pragma unroll
    for(int r=0;r<16;++r){const int orow=crow(r,hi);
      #pragma unroll
      for(int d0=0;d0<2;++d0)stg[orow*64+d0*32+r32]=__float2bfloat16(o[d0][r]*rli[r]);}
    asm volatile("s_waitcnt lgkmcnt(0)":::"memory");
    #pragma unroll
    for(int i=0;i<4;++i){const int row=i*8+(lane>>3),ch=lane&7; const u32x4 v=*(const u32x4*)(stg+row*64+ch*8); ATTN_STORE16(Ow+(long)row*OP+ch*8,v);} }
  asm volatile("s_waitcnt lgkmcnt(0)\n\ts_barrier":::"memory");
  #undef DMA_K
  #undef DMA_V
  #undef CMASK
  #undef START
  #undef RESC
  #undef ROT
}
constexpr int ATTN_LDS_BYTES=LDS_BYTES;
#undef SBAR
#undef WAIT_BAR
}
namespace cg = cooperative_groups;
#define LAS __attribute__((address_space(3)))
typedef unsigned short bf16;
typedef unsigned v4u __attribute__((ext_vector_type(4)));
typedef unsigned v2u __attribute__((ext_vector_type(2)));
typedef float f32x4 __attribute__((ext_vector_type(4)));
typedef float f32x2 __attribute__((ext_vector_type(2)));
typedef short bf16x8 __attribute__((ext_vector_type(8)));

constexpr int NWAVES = 8, NTHREADS = 512;
constexpr int BATCH = 4, SEQ = 4096, DM = 1024, M = BATCH * SEQ, DI = 2048;
constexpr float EPS = 1e-6f;
constexpr size_t MiB = 1u << 20;
constexpr size_t WS_MOD = 0;
constexpr size_t WS_BAR = 512 * 1024, WS_BAR_BYTES = 16384;
constexpr size_t WS_WGT = 256 * 1024;
constexpr size_t WS_W0T = 1 * MiB;
constexpr size_t WS_WO0T = 17 * MiB;
constexpr size_t WS_W1T = 21 * MiB;
constexpr size_t WS_WO1T = 33 * MiB;
constexpr size_t WS_ROPE = 37 * MiB;
constexpr size_t WS_DEC = 37 * MiB;
constexpr size_t WS_SSP = 41 * MiB;
constexpr size_t WS_ATTN = 1 * MiB;
constexpr size_t WS_Q = 64 * MiB, WS_K = 128 * MiB, WS_V = 192 * MiB;
constexpr size_t WS_Q1 = 64 * MiB, WS_K1 = 96 * MiB;
constexpr size_t WS_H1 = 128 * MiB, WS_KET = 160 * MiB;
constexpr size_t WS_V1 = 192 * MiB;
constexpr size_t WS_END = 256 * MiB;
constexpr size_t OUT_H0 = 0;
constexpr size_t OUT_OSC = 32 * MiB;
constexpr int LDS_BYTES = 147456;

#define LDS_WAIT() asm volatile("s_waitcnt lgkmcnt(0)" ::: "memory")
#define VM_WAIT() asm volatile("s_waitcnt vmcnt(0)" ::: "memory")
__device__ __forceinline__ unsigned f2bf(float f) { unsigned u = __builtin_bit_cast(unsigned, f); return (u + 0x7fffu + ((u >> 16) & 1u)) >> 16; }
__device__ __forceinline__ unsigned pk2(float lo, float hi) { return f2bf(lo) | (f2bf(hi) << 16); }
__device__ __forceinline__ float bflo(unsigned w) { return __builtin_bit_cast(float, w << 16); }
__device__ __forceinline__ float bfhi(unsigned w) { return __builtin_bit_cast(float, w & 0xffff0000u); }
__device__ __forceinline__ float silu_f(float z) { return z * __builtin_amdgcn_rcpf(1.0f + __builtin_amdgcn_exp2f(-1.4426950408889634f * z)); }
__device__ __forceinline__ float wave_sum(float v) {
#pragma unroll
    for (int o = 1; o < 64; o <<= 1) v += __shfl_xor(v, o);
    return v;
}

struct Args { const void* in[19]; float* out; unsigned char* ws; };

#define XB_TMO      128
#define XB_XCNT(j)  (256  + 64 * (j))
#define XB_XSUB(j)  (1280 + 64 * (j))
#define XB_XGEN(j)  (2304 + 64 * (j))
#define XB_TOP      3328
#define XB_TOPGEN   3392
#define XCD_BAR_WORDS 3456
#define XB_SPIN_CAP (1u << 18)

__device__ __forceinline__ unsigned xb_ld(unsigned* p)              { return __hip_atomic_load(p, __ATOMIC_RELAXED, __HIP_MEMORY_SCOPE_AGENT); }
__device__ __forceinline__ unsigned xb_add(unsigned* p, unsigned v) { return __hip_atomic_fetch_add(p, v, __ATOMIC_RELAXED, __HIP_MEMORY_SCOPE_AGENT); }
__device__ __forceinline__ unsigned xb_xcc_id() { return (unsigned)__builtin_amdgcn_s_getreg((3 << 11) | 20) & 0xFu; }
#define XB_SPIN(cond, bar) do { unsigned _sp = 0; while (cond) { __builtin_amdgcn_s_sleep(1); \
    if ((++_sp & 255u) == 0u) { if (xb_ld(&(bar)[XB_TMO])) break; if (_sp > XB_SPIN_CAP) { atomicAdd(&(bar)[XB_TMO], 1u); break; } } } } while (0)

struct XcdBarrier {
    unsigned* bar; unsigned x;
    volatile LAS unsigned* st;
};

__device__ __forceinline__ XcdBarrier xcd_barrier_post(unsigned* bar, volatile LAS unsigned* st) {
    XcdBarrier b; b.bar = bar; b.x = xb_xcc_id(); b.st = st;
    if (threadIdx.x == 0) (void)xb_add(&bar[XB_XCNT(b.x)], 1u);
    return b;
}
__device__ __forceinline__ void xcd_barrier_complete(unsigned* bar, unsigned x, unsigned& nloc, unsigned& nx) {
    const unsigned G = gridDim.x * gridDim.y * gridDim.z;
    unsigned sum, cnt, mine, sp = 0u;
    for (;;) {
        sum = 0u; cnt = 0u; mine = 0u;
#pragma unroll
        for (unsigned j = 0; j < 16; ++j) { const unsigned c = xb_ld(&bar[XB_XCNT(j)]); sum += c; cnt += (c > 0u) ? 1u : 0u; mine = (j == x) ? c : mine; }
        if (sum == G) break;
        __builtin_amdgcn_s_sleep(1);
        if ((++sp & 255u) == 0u) { if (xb_ld(&bar[XB_TMO])) break; if (sp > XB_SPIN_CAP) { atomicAdd(&bar[XB_TMO], 1u); break; } }
    }
    nloc = mine > 0u ? mine : 1u; nx = cnt > 0u ? cnt : 1u;
}

__device__ __forceinline__ void xcd_barrier(const XcdBarrier& b) {
    asm volatile("s_waitcnt vmcnt(0)" ::: "memory");
    __syncthreads();
    if (threadIdx.x == 0) {
        unsigned* bar = b.bar;
        __builtin_amdgcn_s_waitcnt(0);
        unsigned nloc = b.st[0], nx = b.st[1];
        if (nloc == 0u) { xcd_barrier_complete(bar, b.x, nloc, nx); b.st[0] = nloc; b.st[1] = nx; }
        const unsigned old = xb_add(&bar[XB_XSUB(b.x)], 1u);
        const unsigned gen = old / nloc;
        if (old + 1u == (gen + 1u) * nloc) {
            __builtin_amdgcn_fence(__ATOMIC_RELEASE, "agent");
            asm volatile("s_waitcnt vmcnt(0)" ::: "memory");
            const unsigned og = xb_add(&bar[XB_TOP], 1u);
            const unsigned tg = og / nx;
            if (og + 1u == (tg + 1u) * nx) xb_add(&bar[XB_TOPGEN], 1u);
            else XB_SPIN(xb_ld(&bar[XB_TOPGEN]) == tg, bar);
            __builtin_amdgcn_fence(__ATOMIC_ACQUIRE, "agent");
            xb_add(&bar[XB_XGEN(b.x)], 1u);
            asm volatile("s_waitcnt vmcnt(0)" ::: "memory");
        } else {
            XB_SPIN(xb_ld(&bar[XB_XGEN(b.x)]) == gen, bar);
            __builtin_amdgcn_fence(__ATOMIC_ACQUIRE, "agent");
            asm volatile("s_waitcnt vmcnt(0)" ::: "memory");
        }
    }
    __syncthreads();
}

struct EpiQKV0 {
    static constexpr bool PERM = true, AFTER_DRAIN = false;
    bf16* Q; bf16* K; bf16* V; const float* rope;
    __device__ __forceinline__ void operator()(const pg8::f32x4 (&acc)[2][2][4][2], const pg8::Unit& u, int wr, int wc, int fr, int fq) const {
        const int row0 = u.pm * 256 + wr * 64 + fr; const int colt = u.pn * 256; const int t = colt >> 11;
        const int cr0 = (colt & 2047) + wc * 32 + 8 * fq;
        bf16* base = Q + (size_t)t * (size_t)(32u << 20);
        if (t < 2) {
            const int g4 = 4 * (4 * (wc & 1) + fq);
            const float sc = t == 0 ? 0.125f * 1.4426950408889634f : 1.0f;
#pragma unroll
            for (int ai = 0; ai < 2; ++ai)
#pragma unroll
                for (int m = 0; m < 4; ++m) {
                    const int row = row0 + ai * 128 + m * 16;
                    const f32x4 cs0 = *(const f32x4*)(rope + ((size_t)row * 32 + g4) * 2), cs1 = *(const f32x4*)(rope + ((size_t)row * 32 + g4) * 2 + 4);
                    const float c0 = cs0[0] * sc, s0 = cs0[1] * sc, c1 = cs0[2] * sc, s1 = cs0[3] * sc, c2 = cs1[0] * sc, s2 = cs1[1] * sc, c3 = cs1[2] * sc, s3 = cs1[3] * sc;
                    bf16* rowp = base + (size_t)row * 2048 + cr0;
#pragma unroll
                    for (int bj = 0; bj < 2; ++bj) {
                        const pg8::f32x4 a = acc[ai][bj][m][0], b = acc[ai][bj][m][1];
                        v4u w;
                        w.x = pk2(a[0] * c0 - b[0] * s0, a[1] * c1 - b[1] * s1); w.y = pk2(a[2] * c2 - b[2] * s2, a[3] * c3 - b[3] * s3);
                        w.z = pk2(b[0] * c0 + a[0] * s0, b[1] * c1 + a[1] * s1); w.w = pk2(b[2] * c2 + a[2] * s2, b[3] * c3 + a[3] * s3);
                        *(v4u*)(rowp + bj * 128) = w;
                    }
                }
        } else {
#pragma unroll
            for (int ai = 0; ai < 2; ++ai)
#pragma unroll
                for (int m = 0; m < 4; ++m) {
                    bf16* rowp = base + (size_t)(row0 + ai * 128 + m * 16) * 2048 + cr0;
#pragma unroll
                    for (int bj = 0; bj < 2; ++bj) {
                        const pg8::f32x4 a = acc[ai][bj][m][0], b = acc[ai][bj][m][1];
                        v4u w; w.x = pk2(a[0], a[1]); w.y = pk2(a[2], a[3]); w.z = pk2(b[0], b[1]); w.w = pk2(b[2], b[3]);
                        *(v4u*)(rowp + bj * 128) = w;
                    }
                }
        }
    }
};
struct EpiQKV1 {
    static constexpr bool PERM = true, AFTER_DRAIN = false;
    bf16* Q; bf16* K; bf16* V;
    __device__ __forceinline__ void operator()(const pg8::f32x4 (&acc)[2][2][4][2], const pg8::Unit& u, int wr, int wc, int fr, int fq) const {
        const int row0 = u.pm * 256 + wr * 64 + fr; const int colt = u.pn * 256;
        bf16* base; int pitch, c0;
        if (colt < 2048) { base = Q + (size_t)(colt >> 10) * (size_t)(16u << 20); pitch = 1024; c0 = colt & 1023; } else { base = V; pitch = 2048; c0 = colt - 2048; }
        c0 += wc * 32 + 8 * fq;
#pragma unroll
        for (int ai = 0; ai < 2; ++ai)
#pragma unroll
            for (int m = 0; m < 4; ++m) {
                bf16* rowp = base + (size_t)(row0 + ai * 128 + m * 16) * pitch + c0;
#pragma unroll
                for (int bj = 0; bj < 2; ++bj) {
                    const pg8::f32x4 a = acc[ai][bj][m][0], b = acc[ai][bj][m][1];
                    v4u w; w.x = pk2(a[0], a[1]); w.y = pk2(a[2], a[3]); w.z = pk2(b[0], b[1]); w.w = pk2(b[2], b[3]);
                    *(v4u*)(rowp + bj * 128) = w;
                }
            }
    }
};
template <bool NORM> struct EpiGate {
    static constexpr bool PERM = true, AFTER_DRAIN = false;
    bf16* G; const float* rstd; const float* nw; bool dry;
    __device__ __forceinline__ void operator()(const pg8::f32x4 (&acc)[2][2][4][2], const pg8::Unit& u, int wr, int wc, int fr, int fq) const {
        const int row0 = u.pm * 256 + wr * 64 + fr; const int c0 = u.pn * 256 + wc * 32 + 8 * fq;
        f32x4 wv[2][2];
        if (NORM) {
#pragma unroll
            for (int bj = 0; bj < 2; ++bj) { wv[bj][0] = *(const f32x4*)(nw + ((c0 + bj * 128) & 511)); wv[bj][1] = *(const f32x4*)(nw + ((c0 + bj * 128) & 511) + 4); }
        }
#pragma unroll
        for (int ai = 0; ai < 2; ++ai)
#pragma unroll
            for (int m = 0; m < 4; ++m) {
                const int row = row0 + ai * 128 + m * 16;
                bf16* rowp = G + (size_t)row * 2048 + c0;
                float rs = 1.0f;
                if (NORM) { const f32x4* sp = (const f32x4*)(rstd + ((size_t)row * 4 + (c0 >> 9)) * 32); f32x4 a4 = sp[0];
#pragma unroll
                    for (int q = 1; q < 8; ++q) a4 += sp[q];
                    rs = 1.0f / sqrtf(((a4[0] + a4[1]) + (a4[2] + a4[3])) * (1.0f / 512.0f) + EPS); }
#pragma unroll
                for (int bj = 0; bj < 2; ++bj) {
                    const pg8::f32x4 a = acc[ai][bj][m][0], b = acc[ai][bj][m][1];
                    const v4u on = *(const v4u*)(rowp + bj * 128);
                    float o[8] = {bflo(on.x), bfhi(on.x), bflo(on.y), bfhi(on.y), bflo(on.z), bfhi(on.z), bflo(on.w), bfhi(on.w)};
                    if (NORM) {
#pragma unroll
                        for (int i = 0; i < 4; ++i) { o[i] *= rs * wv[bj][0][i]; o[4 + i] *= rs * wv[bj][1][i]; }
                    }
                    v4u w;
                    w.x = pk2(o[0] * silu_f(a[0]), o[1] * silu_f(a[1])); w.y = pk2(o[2] * silu_f(a[2]), o[3] * silu_f(a[3]));
                    w.z = pk2(o[4] * silu_f(b[0]), o[5] * silu_f(b[1])); w.w = pk2(o[6] * silu_f(b[2]), o[7] * silu_f(b[3]));
                    if (!dry) *(v4u*)(rowp + bj * 128) = w;
                }
            }
    }
};
struct EpiRes {
    static constexpr bool PERM = true, AFTER_DRAIN = false;
    const float* xin; float* xout; const float* gate; bool dry;
    __device__ __forceinline__ void operator()(const pg8::f32x4 (&acc)[2][2][4][2], const pg8::Unit& u, int wr, int wc, int fr, int fq) const {
        const int row0 = u.pm * 256 + wr * 64 + fr; const int c0 = u.pn * 256 + wc * 32 + 8 * fq; const int b = u.pm >> 4;
        f32x4 gv[2][2];
#pragma unroll
        for (int bj = 0; bj < 2; ++bj) { gv[bj][0] = *(const f32x4*)(gate + b * 3072 + c0 + bj * 128); gv[bj][1] = *(const f32x4*)(gate + b * 3072 + c0 + bj * 128 + 4); }
#pragma unroll
        for (int ai = 0; ai < 2; ++ai)
#pragma unroll
            for (int m = 0; m < 4; ++m) {
                const size_t off = (size_t)(row0 + ai * 128 + m * 16) * 1024 + c0;
#pragma unroll
                for (int bj = 0; bj < 2; ++bj) {
                    const f32x4 x0 = *(const f32x4*)(xin + off + bj * 128), x1 = *(const f32x4*)(xin + off + bj * 128 + 4);
                    const pg8::f32x4 a = acc[ai][bj][m][0], b2 = acc[ai][bj][m][1];
                    f32x4 o0, o1;
#pragma unroll
                    for (int i = 0; i < 4; ++i) { o0[i] = x0[i] + gv[bj][0][i] * a[i]; o1[i] = x1[i] + gv[bj][1][i] * b2[i]; }
                    if (!dry) { *(f32x4*)(xout + off + bj * 128) = o0; *(f32x4*)(xout + off + bj * 128 + 4) = o1; }
                }
            }
    }
};

template <int MODE> __device__ __forceinline__ int dest_row(int n) {
    if (MODE == 1 && n < 4096) { const int d = n & 63, dp = d & 31; return (n & ~63) + 8 * (dp >> 2) + 4 * (d >> 5) + (dp & 3); }
    return n;
}
template <int MODE> __device__ __forceinline__ void p0_transpose_item(const float* W, int ld, int K, bf16* WT, int nblk, LAS float* scr, int item, int lane) {
    const int kb = item / nblk, nb = item % nblk, k0 = 64 * kb, n0 = 32 * nb;
#pragma unroll 8
    for (int i = 0; i < 32; ++i) { const int kk = 2 * i + (lane >> 5); scr[kk * 33 + (lane & 31)] = W[(size_t)(k0 + kk) * ld + n0 + (lane & 31)]; }
    LDS_WAIT(); asm volatile("" ::: "memory");
    const int c = lane & 7;
#pragma unroll
    for (int j = 0; j < 4; ++j) { const int n = (lane >> 3) + 8 * j; const LAS float* s = scr + (8 * c) * 33 + n;
        v4u o; o.x = pk2(s[0 * 33], s[1 * 33]); o.y = pk2(s[2 * 33], s[3 * 33]); o.z = pk2(s[4 * 33], s[5 * 33]); o.w = pk2(s[6 * 33], s[7 * 33]);
        *(v4u*)(WT + (size_t)dest_row<MODE>(n0 + n) * K + k0 + 8 * c) = o; }
    LDS_WAIT(); asm volatile("" ::: "memory");
}
__device__ __forceinline__ void norm_row_mod(const float* xrow, const float* g, const float* modb, bf16* orow, int lane) {
    const f32x4* xr = (const f32x4*)xrow + lane;
    f32x4 v[4]; float s = 0.f;
#pragma unroll
    for (int j = 0; j < 4; ++j) { v[j] = xr[64 * j]; s += (v[j][0] * v[j][0] + v[j][1] * v[j][1]) + (v[j][2] * v[j][2] + v[j][3] * v[j][3]); }
    const float rstd = 1.0f / sqrtf(wave_sum(s) * (1.0f / DM) + EPS);
    unsigned long long* o8 = (unsigned long long*)orow + lane;
#pragma unroll
    for (int j = 0; j < 4; ++j) {
        const f32x4 gg = ((const f32x4*)g)[lane + 64 * j], sh = ((const f32x4*)modb)[lane + 64 * j], sc = ((const f32x4*)(modb + 1024))[lane + 64 * j];
        float y[4];
#pragma unroll
        for (int i = 0; i < 4; ++i) y[i] = v[j][i] * rstd * gg[i] * (1.0f + sc[i]) + sh[i];
        o8[64 * j] = (unsigned long long)pk2(y[0], y[1]) | ((unsigned long long)pk2(y[2], y[3]) << 32);
    }
}

__device__ __forceinline__ pg8::f32x4 mfma16(bf16x8 a, bf16x8 b, pg8::f32x4 c) { return __builtin_amdgcn_mfma_f32_16x16x32_bf16(a, b, c, 0, 0, 0); }

#ifndef STOP_AFTER
#define STOP_AFTER 99
#endif
#ifndef DUP_PHASE
#define DUP_PHASE -1
#endif
#ifndef DUP_N
#define DUP_N 2
#endif
#define PHASE_LOOP(k) for (int rep_ = 0; rep_ < ((DUP_PHASE == (k)) ? DUP_N : 1); ++rep_)
#define DRY(k) (DUP_PHASE == (k) && rep_ > 0)

__global__ void __launch_bounds__(NTHREADS, 2) fwd_mega(Args args) {
    extern __shared__ __attribute__((aligned(16))) unsigned char lds_raw[];
    cg::grid_group grid = cg::this_grid();
    LAS unsigned char* lds = (LAS unsigned char*)lds_raw;
    const int G = gridDim.x, bx = blockIdx.x;
    const int vcu = (G % 8 == 0) ? (bx % 8) * (G / 8) + bx / 8 : bx;
    const int NGW = G * NWAVES;
#define FRESH_IDS() int tid_ = threadIdx.x; asm volatile("" : "+v"(tid_)); const int tid = tid_, lane = tid & 63, wid = __builtin_amdgcn_readfirstlane(tid >> 6), gw = bx * NWAVES + wid; (void)gw; (void)lane; (void)tid
    unsigned char* ws = args.ws;
    unsigned char* outb = (unsigned char*)args.out;
    if (ws == nullptr) grid.sync();
    volatile LAS unsigned* bst = (volatile LAS unsigned*)(lds + LDS_BYTES - 64);
    if (threadIdx.x < 2) bst[threadIdx.x] = 0u;
    __syncthreads();
    const XcdBarrier gbar = xcd_barrier_post((unsigned*)(ws + WS_BAR), bst);
#define GSYNC() xcd_barrier(gbar)
    const float* x = (const float*)args.in[0];
    const float* cvec = (const float*)args.in[1];
    const int* positions = (const int*)args.in[2];
    const float* ada_w = (const float*)args.in[3];
    const float* ada_b = (const float*)args.in[4];
    const float* norm_g = (const float*)args.in[5];
    const float* da_w_in = (const float*)args.in[6];
    const float* lq1 = (const float*)args.in[7];
    const float* lk1 = (const float*)args.in[8];
    const float* lq2 = (const float*)args.in[9];
    const float* lk2 = (const float*)args.in[10];
    const float* subln_w = (const float*)args.in[11];
    const float* da_w_out = (const float*)args.in[12];
    const float* gla_w_in = (const float*)args.in[13];
    const float* gla_w_gate_up = (const float*)args.in[14];
    const float* gla_b_gate = (const float*)args.in[15];
    const float* gla_norm_w = (const float*)args.in[16];
    const float* gla_w_out = (const float*)args.in[17];
    const float* final_g = (const float*)args.in[18];
    float* mod = (float*)(ws + WS_MOD);
    bf16* WgT = (bf16*)(ws + WS_WGT);
    bf16* W0t = (bf16*)(ws + WS_W0T); bf16* Wo0t = (bf16*)(ws + WS_WO0T); bf16* W1t = (bf16*)(ws + WS_W1T); bf16* Wo1t = (bf16*)(ws + WS_WO1T);
    float* rope = (float*)(ws + WS_ROPE);
    bf16* H0 = (bf16*)(outb + OUT_H0);
    bf16* Qb = (bf16*)(ws + WS_Q); bf16* Kb = (bf16*)(ws + WS_K); bf16* Vb = (bf16*)(ws + WS_V);

    {
        FRESH_IDS();
        LAS float* red = (LAS float*)lds;
        for (int item = bx; item < 96; item += G) {
            const int layer = item / 48, cgp = item % 48;
            const float* W = ada_w + (size_t)layer * 1024 * 3072 + cgp * 64 + lane;
            float a0 = 0.f, a1 = 0.f, a2 = 0.f, a3 = 0.f;
#pragma unroll 8
            for (int k = 128 * wid; k < 128 * wid + 128; ++k) {
                const float w = W[(size_t)k * 3072];
                a0 += cvec[k] * w; a1 += cvec[1024 + k] * w; a2 += cvec[2048 + k] * w; a3 += cvec[3072 + k] * w;
            }
            red[(wid * 4 + 0) * 64 + lane] = a0; red[(wid * 4 + 1) * 64 + lane] = a1; red[(wid * 4 + 2) * 64 + lane] = a2; red[(wid * 4 + 3) * 64 + lane] = a3;
            __syncthreads();
            if (tid < 256) {
                const int b = tid >> 6; float s = 0.f;
#pragma unroll
                for (int w = 0; w < 8; ++w) s += red[(w * 4 + b) * 64 + lane];
                mod[(size_t)(layer * 4 + b) * 3072 + cgp * 64 + lane] = s + ada_b[layer * 3072 + cgp * 64 + lane];
            }
            __syncthreads();
        }
        LAS float* scr = (LAS float*)(lds + wid * 16384);
        constexpr int I_W0 = 16 * 256, I_W1 = 16 * 192, I_WO = 32 * 32, NITEMS = I_W0 + I_W1 + 2 * I_WO;
        for (int it = gw; it < NITEMS; it += NGW) {
            int r = it;
            if (r < I_W0) { p0_transpose_item<1>(da_w_in, 8192, 1024, W0t, 256, scr, r, lane); continue; } r -= I_W0;
            if (r < I_W1) { p0_transpose_item<0>(gla_w_in, 6160, 1024, W1t, 192, scr, r, lane); continue; } r -= I_W1;
            if (r < I_WO) { p0_transpose_item<0>(da_w_out, 1024, 2048, Wo0t, 32, scr, r, lane); continue; } r -= I_WO;
            p0_transpose_item<0>(gla_w_out, 1024, 2048, Wo1t, 32, scr, r, lane);
        }
        const int gt = bx * NTHREADS + tid, NGT = G * NTHREADS;
        for (int id = gt; id < 16 * 1024; id += NGT) { const int r = id & 15, k = id >> 4; WgT[r * 1024 + k] = (bf16)f2bf(gla_w_in[(size_t)k * 6160 + 6144 + r]); }
        for (int id = gt; id < M * 32; id += NGT) {
            const int row = id >> 5, i = id & 31;
            const float inv = __builtin_amdgcn_exp2f(-(float)i * (13.287712379549449f / 32.0f));
            const float ang = (float)positions[row] * inv;
            const double t = (double)ang * 0.15915494309189535; const float frc = (float)(t - __builtin_rint(t));
            f32x2 cs; cs[0] = __builtin_amdgcn_cosf(frc); cs[1] = __builtin_amdgcn_sinf(frc);
            *(f32x2*)(rope + (size_t)id * 2) = cs;
        }
    }
    GSYNC();
    PHASE_LOOP(0) { FRESH_IDS(); for (int m = gw; m < M; m += NGW) norm_row_mod(x + (size_t)m * DM, norm_g, mod + (size_t)(m >> 12) * 3072, H0 + (size_t)m * DM, lane);
    GSYNC(); }
#if STOP_AFTER >= 1
    PHASE_LOOP(1) {
        pg8::Gemm g{H0, W0t, M, 6144, 1024}; pg8::StaticOrder S; S.init(M, 6144, G, bx);
        EpiQKV0 E{Qb, Kb, Vb, rope};
        pg8::gemm_phase<EpiQKV0, pg8::StaticOrder, true, true>(lds, g, S, E);
    GSYNC(); }
    PHASE_LOOP(2) {
        float lam;
        { FRESH_IDS(); const float p1 = wave_sum(lq1[lane] * lk1[lane]), p2 = wave_sum(lq2[lane] * lk2[lane]); lam = __builtin_bit_cast(float, __builtin_amdgcn_readfirstlane(__builtin_bit_cast(int, __expf(p1) - __expf(p2) + 0.2f))); }
        attn_body::bf16* Osc = (attn_body::bf16*)(outb + OUT_OSC + (size_t)bx * 131072);
        for (int v = vcu; v < 256; v += G) {
            const int bh = v >> 2, b = bh >> 4, h16 = bh & 15, s = v & 3;
            for (int gi = 0; gi < 4; ++gi) {
                const int qb = (gi == 0) ? s : (gi == 1) ? 7 - s : (gi == 2) ? 8 + s : 15 - s;
                const size_t row0 = (size_t)b * SEQ + (size_t)qb * 256;
                for (int sub = 0; sub < 4; ++sub) {
                    const int map = sub >> 1, vh = sub & 1, h32 = 2 * h16 + map;
                    attn_body::attn_unit<8>(qb, (const attn_body::bf16*)Qb + row0 * 2048 + h32 * 64, (const attn_body::bf16*)Kb + (size_t)b * SEQ * 2048 + h32 * 64,
                                            (const attn_body::bf16*)Vb + (size_t)b * SEQ * 2048 + h16 * 128 + vh * 64, Osc + sub * 16384, (char*)lds_raw);
                }
                VM_WAIT(); __syncthreads(); __builtin_amdgcn_fence(__ATOMIC_ACQUIRE, "agent");
                {
                    FRESH_IDS();
                    const int row = tid >> 1, vh = tid & 1;
                    const bf16* p0 = (const bf16*)Osc + (0 + vh) * 16384 + row * 64; const bf16* p1 = (const bf16*)Osc + (2 + vh) * 16384 + row * 64;
                    float d[64]; float ss = 0.f;
#pragma unroll
                    for (int c8 = 0; c8 < 8; ++c8) {
                        const v4u a = *(const v4u*)(p0 + 8 * c8), bq = *(const v4u*)(p1 + 8 * c8);
                        d[8 * c8 + 0] = bflo(a.x) - lam * bflo(bq.x); d[8 * c8 + 1] = bfhi(a.x) - lam * bfhi(bq.x);
                        d[8 * c8 + 2] = bflo(a.y) - lam * bflo(bq.y); d[8 * c8 + 3] = bfhi(a.y) - lam * bfhi(bq.y);
                        d[8 * c8 + 4] = bflo(a.z) - lam * bflo(bq.z); d[8 * c8 + 5] = bfhi(a.z) - lam * bfhi(bq.z);
                        d[8 * c8 + 6] = bflo(a.w) - lam * bflo(bq.w); d[8 * c8 + 7] = bfhi(a.w) - lam * bfhi(bq.w);
                    }
#pragma unroll
                    for (int i = 0; i < 64; ++i) ss += d[i] * d[i];
                    ss += __shfl_xor(ss, 1);
                    const float rs = 0.8f / sqrtf(ss * (1.0f / 128.0f) + EPS);
                    bf16* op = Qb + (row0 + row) * 2048 + h16 * 128 + vh * 64;
#pragma unroll
                    for (int c8 = 0; c8 < 8; ++c8) {
                        const f32x4 w0 = *(const f32x4*)(subln_w + vh * 64 + 8 * c8), w1 = *(const f32x4*)(subln_w + vh * 64 + 8 * c8 + 4);
                        v4u w;
                        w.x = pk2(d[8 * c8 + 0] * rs * w0[0], d[8 * c8 + 1] * rs * w0[1]); w.y = pk2(d[8 * c8 + 2] * rs * w0[2], d[8 * c8 + 3] * rs * w0[3]);
                        w.z = pk2(d[8 * c8 + 4] * rs * w1[0], d[8 * c8 + 5] * rs * w1[1]); w.w = pk2(d[8 * c8 + 6] * rs * w1[2], d[8 * c8 + 7] * rs * w1[3]);
                        if (!DRY(2)) *(v4u*)(op + 8 * c8) = w;
                    }
                }
            }
        }
    GSYNC(); }
    PHASE_LOOP(3) {
        pg8::Gemm g{H0, W0t + (size_t)6144 * 1024, M, 2048, 1024}; pg8::StaticOrder S; S.init(M, 2048, G, bx);
        EpiGate<false> E{Qb, nullptr, nullptr, DRY(3)};
        pg8::gemm_phase<EpiGate<false>, pg8::StaticOrder, true, true>(lds, g, S, E);
    GSYNC(); }
    PHASE_LOOP(4) {
        pg8::Gemm g{Qb, Wo0t, M, 1024, 2048}; pg8::StaticOrder S; S.init(M, 1024, G, bx);
        EpiRes E{x, args.out, mod + 2048, false};
        pg8::gemm_phase<EpiRes, pg8::StaticOrder, true, true>(lds, g, S, E);
    GSYNC(); }
#else
    { FRESH_IDS(); for (size_t i = (size_t)bx * NTHREADS + tid; i < (size_t)M * DM / 4; i += (size_t)G * NTHREADS) ((f32x4*)args.out)[i] = ((const f32x4*)x)[i]; }
    GSYNC();
#endif
#if STOP_AFTER >= 2
    bf16* H1 = (bf16*)(ws + WS_H1); bf16* Q1 = (bf16*)(ws + WS_Q1); bf16* K1 = (bf16*)(ws + WS_K1); bf16* V1 = (bf16*)(ws + WS_V1); bf16* keT = (bf16*)(ws + WS_KET);
    bf16* attnb = (bf16*)(ws + WS_ATTN); float* decb = (float*)(ws + WS_DEC); float* sspart = (float*)(ws + WS_SSP);
    PHASE_LOOP(5) { FRESH_IDS(); for (int m = gw; m < M; m += NGW) norm_row_mod(args.out + (size_t)m * DM, norm_g + 1024, mod + (size_t)(4 + (m >> 12)) * 3072, H1 + (size_t)m * DM, lane);
    GSYNC(); }
    PHASE_LOOP(6) {
        pg8::Gemm g{H1, W1t, M, 4096, 1024}; pg8::StaticOrder S; S.init(M, 4096, G, bx);
        EpiQKV1 E{Q1, K1, V1};
        pg8::gemm_phase<EpiQKV1, pg8::StaticOrder, true, true>(lds, g, S, E);
    GSYNC(); }
    PHASE_LOOP(7) {
        FRESH_IDS();
        const int fr = lane & 15, fq = lane >> 4;
        LAS unsigned char* qdL = lds; LAS unsigned char* kiL = lds + 33792;
        LAS float* glow = (LAS float*)(lds + 67584); LAS float* red = (LAS float*)(lds + 71680); LAS float* pref = (LAS float*)(lds + 104448);
        LAS float* wgL = (LAS float*)(lds + 112640);
        bf16x8 bfr[4];
#pragma unroll
        for (int ks = 0; ks < 4; ++ks) bfr[ks] = *(const bf16x8*)(WgT + fr * 1024 + 128 * wid + 32 * ks + 8 * fq);
        bf16x8 afr[4][4]; v2u qw[8], kw[8];
#define P7_LOAD(it_) do { const int b_ = (it_) >> 8, n_ = ((it_) >> 2) & 63, h_ = (it_) & 3; const size_t r0_ = (size_t)b_ * SEQ + (size_t)n_ * 64; \
            _Pragma("unroll") for (int ks = 0; ks < 4; ++ks) _Pragma("unroll") for (int ti = 0; ti < 4; ++ti) afr[ks][ti] = *(const bf16x8*)(H1 + (r0_ + 16 * ti + fr) * 1024 + 128 * wid + 32 * ks + 8 * fq); \
            _Pragma("unroll") for (int rr = 0; rr < 8; ++rr) { const size_t ro_ = (r0_ + 8 * wid + rr) * 1024 + h_ * 256 + 4 * lane; qw[rr] = *(const v2u*)(Q1 + ro_); kw[rr] = *(const v2u*)(K1 + ro_); } } while (0)
        int hprev = -1;
        if (vcu < 1024) P7_LOAD(vcu);
        for (int item = vcu; item < 1024; item += G) {
            const int b = item >> 8, n = (item >> 2) & 63, h = item & 3, bhn = (b * 4 + h) * 64 + n;
            const size_t r0 = (size_t)b * SEQ + (size_t)n * 64;
            const int col = h * 256 + 4 * lane;
            if (h != hprev) {
                __syncthreads();
#pragma unroll
                for (int q = 0; q < 2; ++q) { const int idx = tid + 512 * q, r = idx >> 6, c4 = idx & 63; *(LAS f32x4*)(wgL + r * 256 + 4 * c4) = *(const f32x4*)(gla_w_gate_up + r * 1024 + h * 256 + 4 * c4); }
                hprev = h;
            }
            {
                pg8::f32x4 gacc[4];
#pragma unroll
                for (int ti = 0; ti < 4; ++ti) gacc[ti] = (pg8::f32x4){0.f, 0.f, 0.f, 0.f};
#pragma unroll
                for (int ks = 0; ks < 4; ++ks)
#pragma unroll
                    for (int ti = 0; ti < 4; ++ti) gacc[ti] = mfma16(afr[ks][ti], bfr[ks], gacc[ti]);
#pragma unroll
                for (int ti = 0; ti < 4; ++ti)
#pragma unroll
                    for (int e = 0; e < 4; ++e) red[wid * 1024 + (16 * ti + 4 * fq + e) * 16 + fr] = gacc[ti][e];
            }
            __syncthreads();
#pragma unroll
            for (int q = 0; q < 2; ++q) { const int idx = tid + 512 * q; float s = 0.f;
#pragma unroll
                for (int w = 0; w < 8; ++w) s += red[w * 1024 + idx];
                glow[idx] = s; }
            __syncthreads();
            f32x4 bc[8];
            {
                const f32x4 bg = *(const f32x4*)(gla_b_gate + col);
#pragma unroll
                for (int rr = 0; rr < 8; ++rr) bc[rr] = bg;
#pragma unroll
                for (int r = 0; r < 16; ++r) { const f32x4 w = *(const LAS f32x4*)(wgL + r * 256 + 4 * lane);
#pragma unroll
                    for (int rr = 0; rr < 8; ++rr) { const float gl = glow[(8 * wid + rr) * 16 + r]; bc[rr] += w * gl; } }
                f32x4 run = (f32x4){0.f, 0.f, 0.f, 0.f};
#pragma unroll
                for (int rr = 0; rr < 8; ++rr) {
#pragma unroll
                    for (int i = 0; i < 4; ++i) { const float gg = bc[rr][i]; const float ls = fminf(gg, 0.f) - __logf(1.0f + __expf(-fabsf(gg))); run[i] += ls * (1.0f / 16.0f); }
                    bc[rr] = run;
                }
                *(LAS f32x4*)(pref + wid * 256 + 4 * lane) = run;
            }
            __syncthreads();
            f32x4 off = (f32x4){0.f, 0.f, 0.f, 0.f}, tot = (f32x4){0.f, 0.f, 0.f, 0.f};
#pragma unroll
            for (int w = 0; w < 8; ++w) { const f32x4 p = *(const LAS f32x4*)(pref + w * 256 + 4 * lane); tot += p; if (w < wid) off += p; }
            unsigned kew[4][4];
#pragma unroll
            for (int rr = 0; rr < 8; ++rr) {
                const size_t ro = (r0 + 8 * wid + rr) * 1024 + col;
                const float qv[4] = {bflo(qw[rr].x), bfhi(qw[rr].x), bflo(qw[rr].y), bfhi(qw[rr].y)}, kv[4] = {bflo(kw[rr].x), bfhi(kw[rr].x), bflo(kw[rr].y), bfhi(kw[rr].y)};
                float qd[4], ki[4], ke[4];
#pragma unroll
                for (int i = 0; i < 4; ++i) { const float bb = bc[rr][i] + off[i]; qd[i] = qv[i] * __expf(bb) * 0.0625f; ki[i] = kv[i] * __expf(-bb); ke[i] = kv[i] * __expf(tot[i] - bb); }
                v2u qo; qo.x = pk2(qd[0], qd[1]); qo.y = pk2(qd[2], qd[3]);
                v2u ko; ko.x = pk2(ki[0], ki[1]); ko.y = pk2(ki[2], ki[3]);
                if (!DRY(7)) *(v2u*)(Q1 + ro) = qo;
                *(LAS v2u*)(qdL + (8 * wid + rr) * 528 + 8 * lane) = qo;
                *(LAS v2u*)(kiL + (8 * wid + rr) * 528 + 8 * lane) = ko;
#pragma unroll
                for (int i = 0; i < 4; ++i) { const unsigned hb = f2bf(ke[i]); if (rr & 1) kew[i][rr >> 1] |= hb << 16; else kew[i][rr >> 1] = hb; }
            }
#pragma unroll
            for (int i = 0; i < 4; ++i) { v4u w; w.x = kew[i][0]; w.y = kew[i][1]; w.z = kew[i][2]; w.w = kew[i][3];
                if (!DRY(7)) *(v4u*)(keT + ((size_t)bhn * 256 + 4 * lane + i) * 64 + 8 * wid) = w; }
            if (wid == 0 && !DRY(7)) { f32x4 dv;
#pragma unroll
                for (int i = 0; i < 4; ++i) dv[i] = __expf(tot[i]);
                *(f32x4*)(decb + (size_t)bhn * 256 + 4 * lane) = dv; }
            if (item + G < 1024) P7_LOAD(item + G);
            __syncthreads();
            {
                const int ti = wid >> 1;
#pragma unroll
                for (int tjj = 0; tjj < 2; ++tjj) {
                    const int tj = (wid & 1) * 2 + tjj;
                    pg8::f32x4 acc0 = (pg8::f32x4){0.f, 0.f, 0.f, 0.f}, acc1 = acc0;
                    if (tj <= ti) {
#pragma unroll
                        for (int ks = 0; ks < 8; ks += 2) {
                            const bf16x8 kf = *(const LAS bf16x8*)(kiL + (16 * tj + fr) * 528 + (32 * ks + 8 * fq) * 2);
                            const bf16x8 qf = *(const LAS bf16x8*)(qdL + (16 * ti + fr) * 528 + (32 * ks + 8 * fq) * 2);
                            const bf16x8 kf1 = *(const LAS bf16x8*)(kiL + (16 * tj + fr) * 528 + (32 * ks + 32 + 8 * fq) * 2);
                            const bf16x8 qf1 = *(const LAS bf16x8*)(qdL + (16 * ti + fr) * 528 + (32 * ks + 32 + 8 * fq) * 2);
                            acc0 = mfma16(kf, qf, acc0); acc1 = mfma16(kf1, qf1, acc1);
                        }
                    }
                    const int i = 16 * ti + fr, j0 = 16 * tj + 4 * fq;
                    float o[4];
#pragma unroll
                    for (int e = 0; e < 4; ++e) o[e] = (j0 + e <= i) ? acc0[e] + acc1[e] : 0.f;
                    v2u w; w.x = pk2(o[0], o[1]); w.y = pk2(o[2], o[3]);
                    if (!DRY(7)) *(v2u*)(attnb + ((size_t)bhn * 64 + i) * 64 + j0) = w;
                }
            }
            __syncthreads();
        }
#undef P7_LOAD
    GSYNC(); }
    PHASE_LOOP(8) {
        FRESH_IDS();
        const int fr = lane & 15, fq = lane >> 4;
        LAS unsigned char* qdL = lds; LAS unsigned char* keL = lds + 33792; LAS unsigned char* vTL = lds + 70656; LAS unsigned char* atL = lds + 75264;
        LAS float* decL = (LAS float*)(lds + 84480); LAS unsigned char* sTL = lds + 85504;
        for (int item = vcu; item < 256; item += G) {
            const int bhh = item >> 4, vs = item & 15, b = bhh >> 2, h = bhh & 3;
            pg8::f32x4 S[2][2];
#pragma unroll
            for (int i = 0; i < 2; ++i)
#pragma unroll
                for (int j = 0; j < 2; ++j) S[i][j] = (pg8::f32x4){0.f, 0.f, 0.f, 0.f};
            __syncthreads();
            for (int i = tid; i < 16896 / 4; i += NTHREADS) ((LAS unsigned*)sTL)[i] = 0u;
            v4u rqA[4], rkA[4], raA; v2u rvA; f32x4 rdA;
            v4u rqB[4], rkB[4], raB; v2u rvB; f32x4 rdB;
#define P8_LOAD(X, nn) do { const size_t r0_ = (size_t)b * SEQ + (size_t)(nn) * 64; const size_t blk_ = (size_t)(bhh * 64 + (nn)); \
                _Pragma("unroll") for (int q = 0; q < 4; ++q) { const int p = tid + 512 * q; rq##X[q] = *(const v4u*)(Q1 + (r0_ + (p >> 5)) * 1024 + h * 256 + 8 * (p & 31)); rk##X[q] = *(const v4u*)(keT + blk_ * 16384 + (size_t)p * 8); } \
                rv##X = *(const v2u*)(V1 + (r0_ + (tid >> 3)) * 2048 + h * 512 + vs * 32 + 4 * (tid & 7)); \
                ra##X = *(const v4u*)(attnb + blk_ * 4096 + (size_t)tid * 8); \
                if (tid < 64) rd##X = *(const f32x4*)(decb + blk_ * 256 + 4 * tid); } while (0)
#define P8_STAGE(X) do { \
                _Pragma("unroll") for (int q = 0; q < 4; ++q) { const int p = tid + 512 * q; *(LAS v4u*)(qdL + (p >> 5) * 528 + (p & 31) * 16) = rq##X[q]; *(LAS v4u*)(keL + (p >> 3) * 144 + (p & 7) * 16) = rk##X[q]; } \
                { const int j = tid >> 3, c4 = 4 * (tid & 7); \
                  *(LAS unsigned short*)(vTL + (c4 + 0) * 144 + j * 2) = (unsigned short)(rv##X.x & 0xffffu); *(LAS unsigned short*)(vTL + (c4 + 1) * 144 + j * 2) = (unsigned short)(rv##X.x >> 16); \
                  *(LAS unsigned short*)(vTL + (c4 + 2) * 144 + j * 2) = (unsigned short)(rv##X.y & 0xffffu); *(LAS unsigned short*)(vTL + (c4 + 3) * 144 + j * 2) = (unsigned short)(rv##X.y >> 16); } \
                *(LAS v4u*)(atL + (tid >> 3) * 144 + (tid & 7) * 16) = ra##X; \
                if (tid < 64) *(LAS f32x4*)(decL + 4 * tid) = rd##X; } while (0)
            const int ib = wid >> 1, vb = wid & 1;
#define P8_STEP(n, XL, XS) do { \
                if ((n) + 2 < 64) P8_LOAD(XL, (n) + 2); \
                const size_t r0 = (size_t)b * SEQ + (size_t)(n) * 64; \
                pg8::f32x4 oa0 = (pg8::f32x4){0.f, 0.f, 0.f, 0.f}, oa1 = oa0; \
                _Pragma("unroll") for (int ks = 0; ks < 8; ks += 2) { \
                    const bf16x8 sf0 = *(const LAS bf16x8*)(sTL + (16 * vb + fr) * 528 + (32 * ks + 8 * fq) * 2); \
                    const bf16x8 qf0 = *(const LAS bf16x8*)(qdL + (16 * ib + fr) * 528 + (32 * ks + 8 * fq) * 2); \
                    const bf16x8 sf1 = *(const LAS bf16x8*)(sTL + (16 * vb + fr) * 528 + (32 * ks + 32 + 8 * fq) * 2); \
                    const bf16x8 qf1 = *(const LAS bf16x8*)(qdL + (16 * ib + fr) * 528 + (32 * ks + 32 + 8 * fq) * 2); \
                    oa0 = mfma16(sf0, qf0, oa0); oa1 = mfma16(sf1, qf1, oa1); } \
                { const bf16x8 vf0 = *(const LAS bf16x8*)(vTL + (16 * vb + fr) * 144 + (8 * fq) * 2); const bf16x8 af0 = *(const LAS bf16x8*)(atL + (16 * ib + fr) * 144 + (8 * fq) * 2); \
                  const bf16x8 vf1 = *(const LAS bf16x8*)(vTL + (16 * vb + fr) * 144 + (32 + 8 * fq) * 2); const bf16x8 af1 = *(const LAS bf16x8*)(atL + (16 * ib + fr) * 144 + (32 + 8 * fq) * 2); \
                  oa0 = mfma16(vf0, af0, oa0); oa1 = mfma16(vf1, af1, oa1); } \
                { const pg8::f32x4 oacc = oa0 + oa1; v2u w; w.x = pk2(oacc[0], oacc[1]); w.y = pk2(oacc[2], oacc[3]); \
                  if (!DRY(8)) *(v2u*)(V1 + (r0 + 16 * ib + fr) * 2048 + h * 512 + vs * 32 + 16 * vb + 4 * fq) = w; \
                  float sq = (oacc[0] * oacc[0] + oacc[1] * oacc[1]) + (oacc[2] * oacc[2] + oacc[3] * oacc[3]); sq += __shfl_xor(sq, 16); sq += __shfl_xor(sq, 32); \
                  if (fq == 0 && !DRY(8)) sspart[((r0 + 16 * ib + fr) * 4 + h) * 32 + vs * 2 + vb] = sq; } \
                _Pragma("unroll") for (int dbi = 0; dbi < 2; ++dbi) { \
                    const int db = 2 * wid + dbi; \
                    const f32x4 dc = *(const LAS f32x4*)(decL + 16 * db + 4 * fq); \
                    _Pragma("unroll") for (int v2 = 0; v2 < 2; ++v2) _Pragma("unroll") for (int e = 0; e < 4; ++e) S[dbi][v2][e] *= dc[e]; \
                    _Pragma("unroll") for (int ks = 0; ks < 2; ++ks) { \
                        const bf16x8 kf = *(const LAS bf16x8*)(keL + (16 * db + fr) * 144 + (32 * ks + 8 * fq) * 2); \
                        _Pragma("unroll") for (int v2 = 0; v2 < 2; ++v2) { \
                            const bf16x8 vf = *(const LAS bf16x8*)(vTL + (16 * v2 + fr) * 144 + (32 * ks + 8 * fq) * 2); \
                            S[dbi][v2] = mfma16(kf, vf, S[dbi][v2]); } } } \
                __syncthreads(); \
                _Pragma("unroll") for (int dbi = 0; dbi < 2; ++dbi) _Pragma("unroll") for (int v2 = 0; v2 < 2; ++v2) { v2u w; w.x = pk2(S[dbi][v2][0], S[dbi][v2][1]); w.y = pk2(S[dbi][v2][2], S[dbi][v2][3]); \
                        *(LAS v2u*)(sTL + (16 * v2 + fr) * 528 + (16 * (2 * wid + dbi) + 4 * fq) * 2) = w; } \
                if ((n) + 1 < 64) P8_STAGE(XS); \
                __syncthreads(); } while (0)
            P8_LOAD(A, 0);
            P8_STAGE(A);
            P8_LOAD(B, 1);
            __syncthreads();
            for (int n = 0; n < 64; n += 2) {
                P8_STEP(n, A, B);
                P8_STEP(n + 1, B, A);
            }
#undef P8_LOAD
#undef P8_STAGE
#undef P8_STEP
        }
    GSYNC(); }
    PHASE_LOOP(10) {
        pg8::Gemm g{H1, W1t + (size_t)4096 * 1024, M, 2048, 1024}; pg8::StaticOrder S; S.init(M, 2048, G, bx);
        EpiGate<true> E{V1, sspart, gla_norm_w, DRY(10)};
        pg8::gemm_phase<EpiGate<true>, pg8::StaticOrder, true, true>(lds, g, S, E);
    GSYNC(); }
    PHASE_LOOP(11) {
        pg8::Gemm g{V1, Wo1t, M, 1024, 2048}; pg8::StaticOrder S; S.init(M, 1024, G, bx);
        EpiRes E{args.out, args.out, mod + 4 * 3072 + 2048, DRY(11)};
        pg8::gemm_phase<EpiRes, pg8::StaticOrder, true, true>(lds, g, S, E);
    GSYNC(); }
#endif
    if (DUP_PHASE == 20) { for (int i = 0; i < 10; ++i) GSYNC(); }
    { FRESH_IDS();
    for (int m = gw; m < M; m += NGW) {
        f32x4* xr = (f32x4*)(args.out + (size_t)m * DM) + lane;
        f32x4 v[4]; float s = 0.f;
#pragma unroll
        for (int j = 0; j < 4; ++j) { v[j] = xr[64 * j]; s += (v[j][0] * v[j][0] + v[j][1] * v[j][1]) + (v[j][2] * v[j][2] + v[j][3] * v[j][3]); }
        const float rstd = 1.0f / sqrtf(wave_sum(s) * (1.0f / DM) + EPS);
#pragma unroll
        for (int j = 0; j < 4; ++j) { const f32x4 gg = ((const f32x4*)final_g)[lane + 64 * j]; f32x4 o;
#pragma unroll
            for (int i = 0; i < 4; ++i) o[i] = v[j][i] * rstd * gg[i];
            xr[64 * j] = o; }
    } }
}

extern "C" void kernel_launch(void* const* d_in, const int* in_sizes, int n_in, void* d_out, int out_size, void* d_ws, size_t ws_size, hipStream_t stream) {
    static int grid = 0;
    if (grid == 0) {
        if (n_in != 19 || out_size != M * DM || ws_size < WS_END) { fprintf(stderr, "kernel_launch: unexpected shapes (n_in %d out %d ws %zu)\n", n_in, out_size, ws_size); grid = -1; return; }
        int dev = 0, cus = 0, per_cu = 0;
        hipGetDevice(&dev); hipDeviceGetAttribute(&cus, hipDeviceAttributeMultiprocessorCount, dev);
        hipFuncSetAttribute((const void*)fwd_mega, hipFuncAttributeMaxDynamicSharedMemorySize, LDS_BYTES);
        hipOccupancyMaxActiveBlocksPerMultiprocessor(&per_cu, (const void*)fwd_mega, NTHREADS, LDS_BYTES);
        (void)hipGetLastError();
        if (per_cu < 1) per_cu = 1;
        grid = cus;
        if (grid > 256) grid = 256;
    }
    if (grid < 0) return;
    if (hipMemsetAsync((char*)d_ws + WS_BAR, 0, WS_BAR_BYTES, stream) != hipSuccess) { fprintf(stderr, "memset failed\n"); return; }
    Args a{};
    for (int i = 0; i < 19; ++i) a.in[i] = d_in[i];
    a.out = (float*)d_out; a.ws = (unsigned char*)d_ws;
    void* kargs[] = {&a};
    hipError_t e = hipLaunchCooperativeKernel((const void*)fwd_mega, dim3(grid), dim3(NTHREADS), kargs, LDS_BYTES, stream);
    if (e != hipSuccess) fprintf(stderr, "cooperative launch failed: %s (grid %d)\n", hipGetErrorString(e), grid);
}
```

```cpp
#include <hip/hip_runtime.h>
#include <hip/hip_cooperative_groups.h>
#include <cstdio>
#include <cstdint>
namespace pg8 {
#define PG8_LAS __attribute__((address_space(3)))
typedef unsigned short bf16_t;
typedef short bf16x8 __attribute__((ext_vector_type(8)));
typedef float f32x4 __attribute__((ext_vector_type(4)));
typedef unsigned u32x4 __attribute__((ext_vector_type(4)));
constexpr int BM = 256, BK = 64, HALF = 128, HTB = HALF * BK * 2  , STAGE_BYTES = 8 * HTB, NXCD = 8, WGM = 8;

__host__ __device__ __forceinline__ int lds_byte(int r, int c) { const int st = (r >> 4) * 2 + (c >> 5), rr = r & 15, cc = c & 31, ob = rr * 64 + cc * 2; return st * 1024 + (ob ^ (((ob >> 9) & 1) << 5)); }
__host__ __device__ __forceinline__ void stage_rc(int b, int& R, int& C) { const int st = b / 1024, sb = b % 1024, swz = sb ^ (((sb >> 9) & 1) << 5); R = (st >> 1) * 16 + swz / 64; C = (st & 1) * 32 + (swz % 64) / 2; }
__host__ __device__ __forceinline__ int perm32(int rho) { const int n = rho >> 4, i = rho & 15; return 8 * (i >> 2) + 4 * n + (i & 3); }

struct Unit { int pm, pn; };
struct Gemm { const bf16_t* A; const bf16_t* Bt; int M, N, K; };

struct StaticOrder {
    int nM, nN, nwg, G, c;
    __host__ __device__ void init(int M, int N, int G_, int c_) { nM = M / BM; nN = N / BM; nwg = nM * nN; G = G_; c = c_; }
    __host__ __device__ bool next(int i, Unit& u) const {
        const long L = (long)i * G + c; if (L >= nwg) return false;
        int wgid = (int)L; { const int q = nwg / NXCD, r = nwg % NXCD, xcd = wgid % NXCD, off = wgid / NXCD; wgid = (xcd < r ? xcd * (q + 1) : r * (q + 1) + (xcd - r) * q) + off; }
        const int nig = WGM * nN, gid = wgid / nig, fm = gid * WGM, gsz = (nM - fm) < WGM ? (nM - fm) : WGM;
        u.pm = fm + ((wgid % nig) % gsz); u.pn = (wgid % nig) / gsz; return true;
    }
    __device__ __forceinline__ void a_ready(const Unit&) const {}
    __device__ __forceinline__ void done(const Unit&) const {}
};

__device__ __forceinline__ unsigned cvt_pk_bf16(float lo, float hi) { unsigned r; asm volatile("v_cvt_pk_bf16_f32 %0, %1, %2" : "=v"(r) : "v"(lo), "v"(hi)); return r; }
typedef float f32x2 __attribute__((ext_vector_type(2)));
__device__ __forceinline__ f32x2 gelu_pk(f32x2 v) {
    const f32x2 av = __builtin_elementwise_abs(v), d = av * 0.2316418882f + 1.0f;
    f32x2 t; t.x = __builtin_amdgcn_rcpf(d.x); t.y = __builtin_amdgcn_rcpf(d.y);
    f32x2 q = t * 0.5307027145f + (-0.7265760135f); q = q * t + 0.7107068705f; q = q * t + (-0.142248368f); q = q * t + 0.127414796f; q = q * t;
    const f32x2 s = (v * v) * (-0.72134752044f);
    f32x2 e; e.x = __builtin_amdgcn_exp2f(s.x); e.y = __builtin_amdgcn_exp2f(s.y);
    const f32x2 m = v * (q * e), r = v - m;
    f32x2 o; o.x = v.x < 0.f ? m.x : r.x; o.y = v.y < 0.f ? m.y : r.y; return o;
}

template <int ACT  > struct EpiBf16 {
    static constexpr bool PERM = true, AFTER_DRAIN = false; static_assert(ACT == 0 || ACT == 1, "EpiBf16: ACT is 0 (none) or 1 (gelu_pk)");
    bf16_t* O; int ldc; const float* bias; int split_cols; size_t split_stride; float scale0;
    __device__ __forceinline__ void operator()(const f32x4 (&acc)[2][2][4][2], const Unit& u, int wr, int wc, int fr, int fq) const {
        const int row0 = u.pm * BM + wr * 64 + fr; int colt = u.pn * BM; bf16_t* base = O;
        float sc = 1.f; if (split_cols) { const int t = colt / split_cols; base += (size_t)t * split_stride; colt -= t * split_cols; if (t == 0) sc = scale0; }
        const int col0 = colt + wc * 32 + 8 * fq, bcol0 = u.pn * BM + wc * 32 + 8 * fq;
        f32x4 bv[2][2];
#pragma unroll
        for (int bj = 0; bj < 2; ++bj)
#pragma unroll
            for (int n = 0; n < 2; ++n) bv[bj][n] = bias ? *(const f32x4*)(bias + bcol0 + bj * HALF + 4 * n) : (f32x4){0.f, 0.f, 0.f, 0.f};
#pragma unroll
        for (int ai = 0; ai < 2; ++ai)
#pragma unroll
            for (int m = 0; m < 4; ++m) { bf16_t* rowp = base + (size_t)(row0 + ai * HALF + m * 16) * ldc + col0;
#pragma unroll
                for (int bj = 0; bj < 2; ++bj) { f32x4 v0 = acc[ai][bj][m][0] + bv[bj][0], v1 = acc[ai][bj][m][1] + bv[bj][1];
                    if (ACT == 1) { f32x2 a = gelu_pk((f32x2){v0[0], v0[1]}), b = gelu_pk((f32x2){v0[2], v0[3]}), c = gelu_pk((f32x2){v1[0], v1[1]}), d = gelu_pk((f32x2){v1[2], v1[3]});
                        v0 = (f32x4){a.x, a.y, b.x, b.y}; v1 = (f32x4){c.x, c.y, d.x, d.y}; }
                    v0 = v0 * sc; v1 = v1 * sc; u32x4 w; w.x = cvt_pk_bf16(v0[0], v0[1]); w.y = cvt_pk_bf16(v0[2], v0[3]); w.z = cvt_pk_bf16(v1[0], v1[1]); w.w = cvt_pk_bf16(v1[2], v1[3]);
                    *(u32x4*)(rowp + bj * HALF) = w; } }
    }
};


template <class Epi, class Sched, bool ALIGN_EPI = false, bool SP2 = false>
__device__ __forceinline__ void gemm_phase(PG8_LAS unsigned char* lds, const Gemm g, const Sched& S, const Epi& E) {
    int tid_ = threadIdx.x; asm volatile("" : "+v"(tid_)); const int tid = tid_, wid = __builtin_amdgcn_readfirstlane(tid >> 6), lane = tid & 63, wr = wid >> 2, wc = wid & 3, fr = lane & 15, fq = lane >> 4;
    const int K = g.K, nt = K / BK;
    unsigned voffA[2], voffB[2];
#pragma unroll
    for (int i = 0; i < 2; ++i) { int R, C; stage_rc(tid * 16 + i * 8192, R, C); const int Rb = Epi::PERM ? ((R & ~31) + perm32(R & 31)) : R;
        voffA[i] = (unsigned)(R * K + C) * 2u; voffB[i] = (unsigned)(Rb * K + C) * 2u; }
    const size_t kstep = (size_t)(BK * 2);
    const size_t hstep = (size_t)HALF * K * 2;
    const size_t tstep = 2 * hstep;
    const unsigned ldsw = (unsigned)wid * 1024u;
    const int aoff = lds_byte(wr * 64 + fr, fq * 8), boff = lds_byte(wc * 32 + fr, fq * 8);
#define PG8_SA(b, h) (((b) * 2 + (h)) * HTB)
#define PG8_SB(b, h) ((4 + (b) * 2 + (h)) * HTB)
#define PG8_STAGE(bufoff, gbase, voff) do { _Pragma("unroll") for (int _i = 0; _i < 2; ++_i) \
        __builtin_amdgcn_global_load_lds((const unsigned*)((const char*)(gbase) + (voff)[_i]), (PG8_LAS unsigned*)(lds + (bufoff) + ldsw + _i * 8192), 16, 0, 0); } while (0)
#define PG8_LDA(dst, b, h) do { _Pragma("unroll") for (int m = 0; m < 4; ++m) _Pragma("unroll") for (int k = 0; k < 2; ++k) dst[m][k] = *(const PG8_LAS bf16x8*)(lds + PG8_SA(b, h) + aoff + m * 2048 + k * 1024); } while (0)
#define PG8_LDB(dst, b, h) do { _Pragma("unroll") for (int n = 0; n < 2; ++n) _Pragma("unroll") for (int k = 0; k < 2; ++k) dst[n][k] = *(const PG8_LAS bf16x8*)(lds + PG8_SB(b, h) + boff + n * 2048 + k * 1024); } while (0)
#define PG8_MMA(ai, bj, At, Bt) do { __builtin_amdgcn_s_setprio(1); _Pragma("unroll") for (int m = 0; m < 4; ++m) _Pragma("unroll") for (int n = 0; n < 2; ++n) _Pragma("unroll") for (int k = 0; k < 2; ++k) \
        acc[ai][bj][m][n] = __builtin_amdgcn_mfma_f32_16x16x32_bf16(Bt[n][k], At[m][k], acc[ai][bj][m][n], 0, 0, 0); __builtin_amdgcn_s_setprio(0); } while (0)
#define PG8_WAIT_V(n) asm volatile("s_waitcnt vmcnt(" #n ")" ::: "memory")
#define PG8_WAIT_L(n) asm volatile("s_waitcnt lgkmcnt(" #n ")" ::: "memory")
#define PG8_BAR __builtin_amdgcn_s_barrier()
#define PG8_SCHED __builtin_amdgcn_sched_barrier(0)
    Unit cur, nxt; int ui = 0;
    if (!S.next(0, cur)) return;
    f32x4 acc[2][2][4][2];
#pragma unroll
    for (int a = 0; a < 2; ++a)
#pragma unroll
        for (int b = 0; b < 2; ++b)
#pragma unroll
            for (int m = 0; m < 4; ++m)
#pragma unroll
                for (int n = 0; n < 2; ++n) acc[a][b][m][n] = (f32x4){0.f, 0.f, 0.f, 0.f};
    bf16x8 At[4][2], B0[2][2], B1[2][2];
    const char* cA = (const char*)g.A + (size_t)cur.pm * tstep; const char* cB = (const char*)g.Bt + (size_t)cur.pn * tstep;
    S.a_ready(cur);
    if constexpr (SP2) {
        PG8_STAGE(PG8_SB(0, 0), cB, voffB); PG8_STAGE(PG8_SB(0, 1), cB + hstep, voffB); PG8_STAGE(PG8_SA(0, 0), cA, voffA); PG8_STAGE(PG8_SA(0, 1), cA + hstep, voffA);
        if (wr == 1) PG8_BAR;
        PG8_WAIT_V(2); PG8_BAR;
        PG8_STAGE(PG8_SB(1, 0), cB + kstep, voffB); PG8_STAGE(PG8_SA(1, 0), cA + kstep, voffA); PG8_STAGE(PG8_SB(1, 1), cB + hstep + kstep, voffB);
        PG8_WAIT_V(6); PG8_BAR;
    } else {
        PG8_STAGE(PG8_SB(0, 0), cB, voffB); PG8_STAGE(PG8_SA(0, 0), cA, voffA); PG8_STAGE(PG8_SB(0, 1), cB + hstep, voffB); PG8_STAGE(PG8_SA(0, 1), cA + hstep, voffA);
        if (wr == 1) PG8_BAR;
        PG8_WAIT_V(4); PG8_BAR;
        PG8_STAGE(PG8_SB(1, 0), cB + kstep, voffB); PG8_STAGE(PG8_SA(1, 0), cA + kstep, voffA); PG8_STAGE(PG8_SB(1, 1), cB + hstep + kstep, voffB);
        PG8_WAIT_V(6); PG8_BAR;
    }
    for (;;) {
        const bool has_next = S.next(ui + 1, nxt);
        const char* nA = has_next ? (const char*)g.A + (size_t)nxt.pm * tstep : cA; const char* nB = has_next ? (const char*)g.Bt + (size_t)nxt.pn * tstep : cB;
        for (int t = 0; t < nt; t += 2) {
            const bool last = (t == nt - 2);
            const char* a1 = cA + (size_t)(t + 1) * kstep;
            const char* a2 = last ? nA : cA + (size_t)(t + 2) * kstep; const char* b2 = last ? nB : cB + (size_t)(t + 2) * kstep;
            const char* a3 = a2 + kstep; const char* b3 = b2 + kstep;
            if (last && has_next) S.a_ready(nxt);
            if constexpr (SP2) {
            PG8_LDB(B0, 0, 0); PG8_LDB(B1, 0, 1); PG8_SCHED; PG8_LDA(At, 0, 0); PG8_STAGE(PG8_SA(1, 1), a1 + hstep, voffA);
            PG8_WAIT_V(8); PG8_WAIT_L(0); PG8_BAR; PG8_MMA(0, 0, At, B0); PG8_MMA(0, 1, At, B1); PG8_BAR; PG8_SCHED;
            PG8_LDA(At, 0, 1); PG8_STAGE(PG8_SB(0, 0), b2, voffB); PG8_STAGE(PG8_SB(0, 1), b2 + hstep, voffB); PG8_STAGE(PG8_SA(0, 0), a2, voffA);
            PG8_WAIT_V(8); PG8_WAIT_L(0); PG8_BAR; PG8_MMA(1, 0, At, B0); PG8_MMA(1, 1, At, B1); PG8_BAR; PG8_SCHED;
            PG8_LDB(B0, 1, 0); PG8_LDB(B1, 1, 1); PG8_SCHED; PG8_LDA(At, 1, 0); PG8_STAGE(PG8_SA(0, 1), a2 + hstep, voffA);
            PG8_WAIT_V(8); PG8_WAIT_L(0); PG8_BAR; PG8_MMA(0, 0, At, B0); PG8_MMA(0, 1, At, B1); PG8_BAR; PG8_SCHED;
            PG8_LDA(At, 1, 1); PG8_STAGE(PG8_SB(1, 0), b3, voffB); PG8_STAGE(PG8_SB(1, 1), b3 + hstep, voffB); PG8_STAGE(PG8_SA(1, 0), a3, voffA);
            PG8_WAIT_V(8); PG8_WAIT_L(0); PG8_BAR; PG8_MMA(1, 0, At, B0); PG8_MMA(1, 1, At, B1); PG8_BAR; PG8_SCHED;
            } else {
            PG8_LDB(B0, 0, 0); PG8_SCHED; PG8_LDA(At, 0, 0); PG8_STAGE(PG8_SA(1, 1), a1 + hstep, voffA);
            PG8_WAIT_L(8); PG8_BAR; PG8_WAIT_L(0); PG8_MMA(0, 0, At, B0); PG8_BAR; PG8_SCHED;
            PG8_LDB(B1, 0, 1); PG8_STAGE(PG8_SB(0, 0), b2, voffB);
            PG8_BAR; PG8_WAIT_L(0); PG8_MMA(0, 1, At, B1); PG8_BAR;
            PG8_LDA(At, 0, 1); PG8_STAGE(PG8_SA(0, 0), a2, voffA);
            PG8_BAR; PG8_WAIT_L(0); PG8_MMA(1, 0, At, B0); PG8_BAR; PG8_SCHED;
            PG8_STAGE(PG8_SB(0, 1), b2 + hstep, voffB);
            PG8_WAIT_V(6); PG8_BAR; PG8_MMA(1, 1, At, B1); PG8_BAR;
            PG8_LDB(B0, 1, 0); PG8_SCHED; PG8_LDA(At, 1, 0); PG8_STAGE(PG8_SA(0, 1), a2 + hstep, voffA);
            PG8_WAIT_L(8); PG8_BAR; PG8_WAIT_L(0); PG8_MMA(0, 0, At, B0); PG8_BAR; PG8_SCHED;
            PG8_LDB(B1, 1, 1); PG8_STAGE(PG8_SB(1, 0), b3, voffB);
            PG8_BAR; PG8_WAIT_L(0); PG8_MMA(0, 1, At, B1); PG8_BAR;
            PG8_LDA(At, 1, 1); PG8_STAGE(PG8_SA(1, 0), a3, voffA);
            PG8_BAR; PG8_WAIT_L(0); PG8_MMA(1, 0, At, B0); PG8_BAR; PG8_SCHED;
            PG8_STAGE(PG8_SB(1, 1), b3 + hstep, voffB);
            PG8_WAIT_V(6); PG8_BAR; PG8_MMA(1, 1, At, B1); PG8_BAR;
            }
        }
        if constexpr (ALIGN_EPI) { if (wr == 0) PG8_BAR; }
        if constexpr (!Epi::AFTER_DRAIN) { E(acc, cur, wr, wc, fr, fq); S.done(cur); }
        if (!has_next) break;
#pragma unroll
        for (int a = 0; a < 2; ++a)
#pragma unroll
            for (int b = 0; b < 2; ++b)
#pragma unroll
                for (int m = 0; m < 4; ++m)
#pragma unroll
                    for (int n = 0; n < 2; ++n) acc[a][b][m][n] = (f32x4){0.f, 0.f, 0.f, 0.f};
        cur = nxt; cA = nA; cB = nB; ++ui;
        if constexpr (ALIGN_EPI) { if (wr == 1) PG8_BAR; }
    }
    PG8_WAIT_V(0);
    if constexpr (!ALIGN_EPI) { if (wr == 0) PG8_BAR; }
    PG8_BAR;
    if constexpr (Epi::AFTER_DRAIN) { E.fused(acc, cur, wr, wc, fr, fq, lds, wid, lane); S.done(cur); }
#undef PG8_SA
#undef PG8_SB
#undef PG8_STAGE
#undef PG8_LDA
#undef PG8_LDB
#undef PG8_MMA
#undef PG8_WAIT_V
#undef PG8_WAIT_L
#undef PG8_BAR
#undef PG8_SCHED
}
}
#include <hip/hip_bf16.h>
#include <cmath>
namespace attn_body {
using bf16=__hip_bfloat16;
using bf16x8=__attribute__((ext_vector_type(8)))short;
using s16x4=__attribute__((ext_vector_type(4)))short;
using f32x16=__attribute__((ext_vector_type(16)))float;
using u32x4=__attribute__((ext_vector_type(4)))unsigned;
constexpr int D=64,QP=2048,KP=2048,VP=2048,OP=64;
constexpr int NW=8,QBLK=32,QB=QBLK*NW,KVBLK=64;
constexpr int ATTN_UNIT_ROWS=QB;
__device__ __forceinline__ int crow(int r,int hi){return (r&3)+8*(r>>2)+4*hi;}
#define SBAR() __builtin_amdgcn_sched_barrier(0)
__device__ __forceinline__ void cmask(f32x16&p0,f32x16&p1,int jb,int qrel,int hi){
  const float NEG=-INFINITY; int kb=64*jb+4*hi;
  #pragma unroll
  for(int r=0;r<16;++r){int kv=kb+(r&3)+8*(r>>2); if(kv>qrel)p0[r]=NEG; if(kv+32>qrel)p1[r]=NEG;}
}

constexpr int NSLOT=3, SLOTB=8192;
constexpr int LDS_K=0, LDS_V=NSLOT*SLOTB, LDS_WS=2*NSLOT*SLOTB, LDS_OST=LDS_WS+NW*64*4, LDS_BYTES=LDS_OST+NW*4096;
constexpr float C2=0.125f*1.4426950408889634f;
__device__ __forceinline__ void glds16(const void*gsrc,unsigned lds_dst){unsigned keep;
  asm volatile("s_mov_b32 %0, m0\n\ts_mov_b32 m0, %2\n\ts_nop 0\n\tglobal_load_lds_dwordx4 %1, off\n\ts_mov_b32 m0, %0":"=&s"(keep):"v"(gsrc),"s"(lds_dst):"memory");}
__device__ __forceinline__ float max3f(float a,float b,float c){float r;asm("v_max3_f32 %0, %1, %2, %3":"=v"(r):"v"(a),"v"(b),"v"(c));return r;}
__device__ __forceinline__ float max2f(float a,float b){float r;asm("v_max_f32_e32 %0, %1, %2":"=v"(r):"v"(a),"v"(b));return r;}
__device__ __forceinline__ float fadd_s(float a,float b){float r;asm("v_add_f32_e32 %0, %1, %2":"=v"(r):"v"(a),"v"(b));return r;}
__device__ __forceinline__ float fsub_s(float a,float b){float r;asm("v_sub_f32_e32 %0, %1, %2":"=v"(r):"v"(a),"v"(b));return r;}
typedef float f32x2_t __attribute__((ext_vector_type(2))); typedef __bf16 bf16x2_t __attribute__((ext_vector_type(2)));
__device__ __forceinline__ unsigned cvtpk_s(float lo,float hi){f32x2_t v={lo,hi};bf16x2_t b=__builtin_convertvector(v,bf16x2_t);return __builtin_bit_cast(unsigned,b);}
#define WAIT_BAR(N) asm volatile("s_waitcnt vmcnt(" #N ") lgkmcnt(0)\n\ts_barrier":::"memory")

__device__ __forceinline__ void qkt(f32x16&p0,f32x16&p1,const char*Kslot,const bf16x8*qr,const f32x16&negm,int r32,int hi){
  const char*kb=Kslot+hi*1024+r32*16;
  #pragma unroll
  for(int d0=0;d0<4;++d0){
    const bf16x8 b0=*reinterpret_cast<const bf16x8*>(kb+d0*2048);
    const bf16x8 b1=*reinterpret_cast<const bf16x8*>(kb+d0*2048+512);
    if(d0==0){p0=__builtin_amdgcn_mfma_f32_32x32x16_bf16(b0,qr[0],negm,0,0,0);p1=__builtin_amdgcn_mfma_f32_32x32x16_bf16(b1,qr[0],negm,0,0,0);}
    else{p0=__builtin_amdgcn_mfma_f32_32x32x16_bf16(b0,qr[d0],p0,0,0,0);p1=__builtin_amdgcn_mfma_f32_32x32x16_bf16(b1,qr[d0],p1,0,0,0);}}
}
typedef __attribute__((address_space(3))) const char* lds_cptr;
typedef short v4i16_t __attribute__((ext_vector_type(4)));
__device__ __forceinline__ void kload8(bf16x8*kf,lds_cptr kp){
  kf[0]=*(const __attribute__((address_space(3))) bf16x8*)(kp);      kf[1]=*(const __attribute__((address_space(3))) bf16x8*)(kp+512);
  kf[2]=*(const __attribute__((address_space(3))) bf16x8*)(kp+2048); kf[3]=*(const __attribute__((address_space(3))) bf16x8*)(kp+2560);
  kf[4]=*(const __attribute__((address_space(3))) bf16x8*)(kp+4096); kf[5]=*(const __attribute__((address_space(3))) bf16x8*)(kp+4608);
  kf[6]=*(const __attribute__((address_space(3))) bf16x8*)(kp+6144); kf[7]=*(const __attribute__((address_space(3))) bf16x8*)(kp+6656);
}
__device__ __forceinline__ void kload2(bf16x8*kf,lds_cptr kp,int j){ kf[2*j]=*(const __attribute__((address_space(3))) bf16x8*)(kp+j*2048); kf[2*j+1]=*(const __attribute__((address_space(3))) bf16x8*)(kp+j*2048+512); }
__device__ __forceinline__ s16x4 vtr(lds_cptr p){ return __builtin_bit_cast(s16x4,__builtin_amdgcn_ds_read_tr16_b64_v4i16((__attribute__((address_space(3))) v4i16_t*)p)); }
__device__ __forceinline__ float rowmax(const f32x16&p0,const f32x16&p1){
  float a=max3f(p0[0],p0[1],p1[0]),b=max3f(p0[2],p0[3],p1[1]);a=max3f(a,p1[2],p1[3]);
  #pragma unroll
  for(int r=4;r<16;r+=4){a=max3f(a,p0[r],p0[r+1]);b=max3f(b,p0[r+2],p0[r+3]);a=max3f(a,p1[r],p1[r+1]);b=max3f(b,p1[r+2],p1[r+3]);}
  const float m=max2f(a,b);
  auto rr=__builtin_amdgcn_permlane32_swap(__float_as_uint(m),__float_as_uint(m),false,false);
  return max2f(__uint_as_float(rr[0]),__uint_as_float(rr[1]));
}
__device__ __forceinline__ void pv(f32x16*o,int vb,bf16x8 pa0,bf16x8 pa1,bf16x8 pa2,bf16x8 pa3){
  #pragma unroll
  for(int d0=0;d0<2;++d0){s16x4 lo[4],hi[4];
    #pragma unroll
    for(int ks=0;ks<4;++ks){
      asm volatile("ds_read_b64_tr_b16 %0,%1 offset:%c2":"=&v"(lo[ks]):"v"(vb),"i"(d0*4096+ks*1024):"memory");
      asm volatile("ds_read_b64_tr_b16 %0,%1 offset:%c2":"=&v"(hi[ks]):"v"(vb),"i"(d0*4096+ks*1024+512):"memory");}
    asm volatile("s_waitcnt lgkmcnt(0)":::"memory");SBAR();
    #define PK(k) (bf16x8){lo[k][0],lo[k][1],lo[k][2],lo[k][3],hi[k][0],hi[k][1],hi[k][2],hi[k][3]}
    o[d0]=__builtin_amdgcn_mfma_f32_32x32x16_bf16(pa0,PK(0),o[d0],0,0,0);
    o[d0]=__builtin_amdgcn_mfma_f32_32x32x16_bf16(pa1,PK(1),o[d0],0,0,0);
    o[d0]=__builtin_amdgcn_mfma_f32_32x32x16_bf16(pa2,PK(2),o[d0],0,0,0);
    o[d0]=__builtin_amdgcn_mfma_f32_32x32x16_bf16(pa3,PK(3),o[d0],0,0,0);
    #undef PK
  }
}

#ifndef ATTN_STORE16
#define ATTN_STORE16(p,v) (*(u32x4*)(p)=(v))
#endif
template<int THRL> __device__ __forceinline__ void attn_unit(int qb,const bf16*Qu,const bf16*__restrict__ Kh,const bf16*__restrict__ Vh,bf16*Ou,char*shm){
  int tid_=threadIdx.x; asm volatile("":"+v"(tid_)); const int tid=tid_,lane=tid&63,r32=lane&31,hi=lane>>5; const int wid=__builtin_amdgcn_readfirstlane(tid>>6);
  const int q0=qb*QB;
  const bf16*Qw=Qu+(long)(wid*QBLK)*QP;
  const unsigned lds0=(unsigned)(uintptr_t)shm;
  float*wsf=(float*)(shm+LDS_WS)+wid*64;
  const bf16*ksrc=Kh+(long)lane*KP+wid*8;
  const bf16*vsrc=Vh+(long)(16*(wid&3)+(lane>>2))*VP+(wid>>2)*32+(lane&3)*8;
  const unsigned kdst=lds0+LDS_K+wid*1024, vdst=lds0+LDS_V+wid*1024;
  #define DMA_K(t,slot) glds16(ksrc+(long)(t)*KVBLK*KP,(unsigned)__builtin_amdgcn_readfirstlane(kdst+(slot)))
  #define DMA_V(t,slot) glds16(vsrc+(long)(t)*KVBLK*VP,(unsigned)__builtin_amdgcn_readfirstlane(vdst+(slot)))
  const int vb0=(int)(lds0+LDS_V)+((lane>>4)&1)*32+(lane&3)*8+(4*hi+((lane&15)>>2))*64;
  const char*Kbase=shm+LDS_K; bf16x8 kf[8];
  const lds_cptr shm3=(lds_cptr)shm; const lds_cptr kp0=shm3+LDS_K+hi*1024+r32*16; const lds_cptr vp0=shm3+LDS_V+((lane>>4)&1)*32+(lane&3)*8+(4*hi+((lane&15)>>2))*64;
  const int NT=(q0+QB)/KVBLK;
  DMA_K(0,0);DMA_V(0,0);DMA_K(1,SLOTB);
  bf16x8 qr[4];
  #pragma unroll
  for(int d0=0;d0<4;++d0)qr[d0]=*reinterpret_cast<const bf16x8*>(&Qw[(long)r32*QP+d0*16+hi*8]);
  float mhat=0.f,l_reg=0.f;f32x16 o[2];o[0]=f32x16{};o[1]=f32x16{};f32x16 negm=f32x16{};asm volatile("":"+v"(negm));
  const int qrel=wid*QBLK+r32;
  #define CMASK(P0,P1,t) do{int jb_=(t)-(NT-4); if(jb_>=0)cmask(P0,P1,jb_,qrel,hi);}while(0)
  bool resc=false;
  #define START(P0,P1) do{ const float rm=rowmax(P0,P1); resc=false; \
    { const float dl=rm; mhat=fadd_s(mhat,dl); \
      _Pragma("unroll") for(int r=0;r<16;++r){P0[r]=fsub_s(P0[r],dl);P1[r]=fsub_s(P1[r],dl);} \
      _Pragma("unroll") for(int r=0;r<16;++r)negm[r]=-mhat; asm volatile("":"+v"(negm)); } \
    _Pragma("unroll") for(int r=0;r<16;++r)P0[r]=__builtin_amdgcn_exp2f(P0[r]); }while(0)
  #define RESC() do{ if(resc){ asm volatile("s_waitcnt lgkmcnt(0)":::"memory"); \
      _Pragma("unroll") for(int d_=0;d_<2;++d_) _Pragma("unroll") for(int r=0;r<16;++r)o[d_][r]*=wsf[crow(r,hi)]; } }while(0)
  f32x16 pA0,pA1,pB0,pB1;
  int sl_prev=0,sl_cur=0,sl_next=SLOTB;
  #define ROT() do{sl_prev=sl_cur;sl_cur=sl_next;sl_next=(sl_next==(NSLOT-1)*SLOTB)?0:sl_next+SLOTB;}while(0)
  DMA_K(2,2*SLOTB);
  WAIT_BAR(3);
  qkt(pA0,pA1,Kbase,qr,negm,r32,hi);asm volatile("s_nop 15\n\ts_nop 7":"+v"(pA0),"+v"(pA1));CMASK(pA0,pA1,0);
  START(pA0,pA1);
  _Pragma("unroll") for(int r=0;r<16;++r)pA1[r]=__builtin_amdgcn_exp2f(pA1[r]);
  WAIT_BAR(0);
  DMA_K(3,0);DMA_V(1,SLOTB);
  ROT();
  kload8(kf,kp0+sl_cur);
  WAIT_BAR(2);
  s16x4 vlo[8],vhi[8]; u32x4 pw0,pw1,pw2,pw3;
  #define PKW(P,B) cvtpk_s(P[B],P[B+1])
  #define PAF(k) __builtin_bit_cast(bf16x8,pw##k)
  #define VFR(i) (bf16x8){vlo[i][0],vlo[i][1],vlo[i][2],vlo[i][3],vhi[i][0],vhi[i][1],vhi[i][2],vhi[i][3]}
  #define PIN(x) asm volatile("":"+v"(x))
  #define MX3(a,b,c) __builtin_fmaxf(__builtin_fmaxf((a),(b)),(c))
  #define GAPA(MF,A0,A1,A2,A3,W0,W1,PW) do{ MF; sacc+=A0; sacc+=A1; sacc+=A2; sacc+=A3; PIN(sacc); W0; W1; PIN(PW); SBAR(); }while(0)
  #define EX(v) __builtin_amdgcn_exp2f(v)
  #define GAPB(MF,X,B) do{ MF; X[B]=EX(X[B]); X[B+1]=EX(X[B+1]); X[B+2]=EX(X[B+2]); X[B+3]=EX(X[B+3]); PIN(X); SBAR(); }while(0)
  #define VRD(i) do{ vlo[i]=vtr(vp_+(((i)>>2)*4096+((i)&3)*1024)); vhi[i]=vtr(vp_+(((i)>>2)*4096+((i)&3)*1024+512)); }while(0)
  #define KRD(G,j) do{ if(G){ kload2(kf,kp0+sl_next,j); SBAR(); } }while(0)
  #define STEP(C0,C1,P0,P1,t,GK,GV,GL) do{ SBAR(); \
    const lds_cptr vp_=vp0+sl_prev; \
    VRD(0); SBAR(); float sacc=(P0[0]+P0[1]); \
    GAPA(C0=__builtin_amdgcn_mfma_f32_32x32x16_bf16(kf[0],qr[0],negm,0,0,0), P0[2],P0[3],P0[4],P0[5],     pw0[0]=PKW(P0,0), pw0[1]=PKW(P0,2), pw0); \
    VRD(4); SBAR(); GAPA(C1=__builtin_amdgcn_mfma_f32_32x32x16_bf16(kf[1],qr[0],negm,0,0,0), P0[6],P0[7],P0[8],P0[9],     pw0[2]=PKW(P0,4), pw0[3]=PKW(P0,6), pw0); \
    VRD(1); SBAR(); GAPA(C0=__builtin_amdgcn_mfma_f32_32x32x16_bf16(kf[2],qr[1],C0,0,0,0),   P0[10],P0[11],P0[12],P0[13], pw1[0]=PKW(P0,8), pw1[1]=PKW(P0,10), pw1); \
    VRD(5); SBAR(); GAPA(C1=__builtin_amdgcn_mfma_f32_32x32x16_bf16(kf[3],qr[1],C1,0,0,0),   P0[14],P0[15],P1[0],P1[1],   pw1[2]=PKW(P0,12),pw1[3]=PKW(P0,14), pw1); \
    VRD(2); SBAR(); GAPA(C0=__builtin_amdgcn_mfma_f32_32x32x16_bf16(kf[4],qr[2],C0,0,0,0),   P1[2],P1[3],P1[4],P1[5],     pw2[0]=PKW(P1,0), pw2[1]=PKW(P1,2), pw2); \
    VRD(6); SBAR(); GAPA(C1=__builtin_amdgcn_mfma_f32_32x32x16_bf16(kf[5],qr[2],C1,0,0,0),   P1[6],P1[7],P1[8],P1[9],     pw2[2]=PKW(P1,4), pw2[3]=PKW(P1,6), pw2); \
    VRD(3); SBAR(); GAPA(C0=__builtin_amdgcn_mfma_f32_32x32x16_bf16(kf[6],qr[3],C0,0,0,0),   P1[10],P1[11],P1[12],P1[13], pw3[0]=PKW(P1,8), pw3[1]=PKW(P1,10), pw3); \
    VRD(7); SBAR(); GAPA(C1=__builtin_amdgcn_mfma_f32_32x32x16_bf16(kf[7],qr[3],C1,0,0,0),   P1[14],P1[15],0.f,0.f,       pw3[2]=PKW(P1,12),pw3[3]=PKW(P1,14), pw3); \
    l_reg+=sacc; \
    if(GK){DMA_K((t)+3,sl_cur);} if(GV){DMA_V((t)+1,sl_next);} \
    CMASK(C0,C1,t); \
    { float a=MX3(C0[0],C0[1],C1[0]),b=MX3(C0[2],C0[3],C1[1]); a=MX3(a,C1[2],C1[3]); \
      _Pragma("unroll") for(int r=4;r<16;r+=4){a=MX3(a,C0[r],C0[r+1]);b=MX3(b,C0[r+2],C0[r+3]);a=MX3(a,C1[r],C1[r+1]);b=MX3(b,C1[r+2],C1[r+3]);} \
      float rm=__builtin_fmaxf(a,b); { auto rr=__builtin_amdgcn_permlane32_swap(__float_as_uint(rm),__float_as_uint(rm),false,false); rm=__builtin_fmaxf(__uint_as_float(rr[0]),__uint_as_float(rr[1])); } \
      resc=false; \
      if(__builtin_expect(__any(rm>(float)THRL),0)){ const float dl=__builtin_fmaxf(rm,0.f); mhat+=dl; \
        _Pragma("unroll") for(int r=0;r<16;++r){C0[r]-=dl;C1[r]-=dl;} \
        _Pragma("unroll") for(int r=0;r<16;++r)negm[r]=-mhat; asm volatile("":"+v"(negm)); \
        const float f=__builtin_amdgcn_exp2f(-dl); l_reg*=f; if(hi==0)wsf[r32]=f; resc=true; } } \
    SBAR(); \
    GAPB(o[0]=__builtin_amdgcn_mfma_f32_32x32x16_bf16(PAF(0),VFR(0),o[0],0,0,0), C0,0); \
    GAPB(o[1]=__builtin_amdgcn_mfma_f32_32x32x16_bf16(PAF(0),VFR(4),o[1],0,0,0), C0,4); \
    KRD(GL,0); GAPB(o[0]=__builtin_amdgcn_mfma_f32_32x32x16_bf16(PAF(1),VFR(1),o[0],0,0,0), C0,8); \
    KRD(GL,1); GAPB(o[1]=__builtin_amdgcn_mfma_f32_32x32x16_bf16(PAF(1),VFR(5),o[1],0,0,0), C0,12); \
    KRD(GL,2); GAPB(o[0]=__builtin_amdgcn_mfma_f32_32x32x16_bf16(PAF(2),VFR(2),o[0],0,0,0), C1,0); \
    KRD(GL,3); GAPB(o[1]=__builtin_amdgcn_mfma_f32_32x32x16_bf16(PAF(2),VFR(6),o[1],0,0,0), C1,4); \
    GAPB(o[0]=__builtin_amdgcn_mfma_f32_32x32x16_bf16(PAF(3),VFR(3),o[0],0,0,0), C1,8); \
    GAPB(o[1]=__builtin_amdgcn_mfma_f32_32x32x16_bf16(PAF(3),VFR(7),o[1],0,0,0), C1,12); \
    }while(0)
  int t=1;
  #undef CMASK
  #define CMASK(P0,P1,t) do{}while(0)
  for(;t+5<NT;t+=2){
    STEP(pB0,pB1,pA0,pA1,t,true,true,true);     WAIT_BAR(2); RESC(); ROT();
    STEP(pA0,pA1,pB0,pB1,t+1,true,true,true);   WAIT_BAR(2); RESC(); ROT();
  }
  #undef CMASK
  #define CMASK(P0,P1,t) do{int jb_=(t)-(NT-4); if(jb_>=0)cmask(P0,P1,jb_,qrel,hi);}while(0)
  #define ENDW(tt) do{ if((tt)+3<NT){WAIT_BAR(2);} else if((tt)+2<NT){WAIT_BAR(1);} else {WAIT_BAR(0);} }while(0)
  for(;t+1<NT;t+=2){
    STEP(pB0,pB1,pA0,pA1,t,(t+3<NT),(t+1<NT),(t+1<NT));       ENDW(t);   RESC(); ROT();
    STEP(pA0,pA1,pB0,pB1,t+1,(t+4<NT),(t+2<NT),(t+2<NT));     ENDW(t+1); RESC(); ROT();
  }
  STEP(pB0,pB1,pA0,pA1,NT-1,false,false,false); RESC();
  { float sacc=pB0[0]+pB0[1]; _Pragma("unroll") for(int r=2;r<16;++r)sacc+=pB0[r]; _Pragma("unroll") for(int r=0;r<16;++r)sacc+=pB1[r]; l_reg+=sacc;
    pw0=(u32x4){PKW(pB0,0),PKW(pB0,2),PKW(pB0,4),PKW(pB0,6)};pw1=(u32x4){PKW(pB0,8),PKW(pB0,10),PKW(pB0,12),PKW(pB0,14)};pw2=(u32x4){PKW(pB1,0),PKW(pB1,2),PKW(pB1,4),PKW(pB1,6)};pw3=(u32x4){PKW(pB1,8),PKW(pB1,10),PKW(pB1,12),PKW(pB1,14)};
    SBAR(); pv(o,vb0+sl_cur,PAF(0),PAF(1),PAF(2),PAF(3)); }
  #undef PKW
  #undef PAF
  #undef VFR
  #undef PIN
  #undef MX3
  #undef GAPA
  #undef GAPB
  #undef EX
  #undef VRD
  #undef KRD
  #undef STEP
  #undef ENDW
  {auto rr=__builtin_amdgcn_permlane32_swap(__float_as_uint(l_reg),__float_as_uint(l_reg),false,false);l_reg=__uint_as_float(rr[0])+__uint_as_float(rr[1]);}
  if(hi==0)wsf[32+r32]=l_reg;asm volatile("s_waitcnt lgkmcnt(0)":::"memory");
  float rli[16];
  #pragma unroll
  for(int r=0;r<16;++r)rli[r]=__builtin_amdgcn_rcpf(wsf[32+crow(r,hi)]);
  bf16*Ow=Ou+(long)(wid*QBLK)*OP;
  { bf16*stg=(bf16*)(shm+LDS_OST)+wid*2048;
    #pragma unroll
    for(int r=0;r<16;++r){const int orow=crow(r,hi);
      #pragma unroll
      for(int d0=0;d0<2;++d0)stg[orow*64+d0*32+r32]=__float2bfloat16(o[d0][r]*rli[r]);}
    asm volatile("s_waitcnt lgkmcnt(0)":::"memory");
    #pragma unroll
    for(int i=0;i<4;++i){const int row=i*8+(lane>>3),ch=lane&7; const u32x4 v=*(const u32x4*)(stg+row*64+ch*8); ATTN_STORE16(Ow+(long)row*OP+ch*8,v);} }
  asm volatile("s_waitcnt lgkmcnt(0)\n\ts_barrier":::"memory");
  #undef DMA_K
  #undef DMA_V
  #undef CMASK
  #undef START
  #undef RESC
  #undef ROT
}
constexpr int ATTN_LDS_BYTES=LDS_BYTES;
#undef SBAR
#undef WAIT_BAR
}
namespace da {
typedef unsigned short bf16;
typedef short bf16x8 __attribute__((ext_vector_type(8)));
typedef short s16x4 __attribute__((ext_vector_type(4)));
typedef float f32x16 __attribute__((ext_vector_type(16)));
typedef float f32x4 __attribute__((ext_vector_type(4)));
typedef unsigned u32x4 __attribute__((ext_vector_type(4)));
constexpr int NW = 8, QBLK = 32, KVBLK = 64, QB = NW * QBLK;
constexpr int QP = 2048, KP = 2048, VP = 2048, OP = 128;
constexpr int SHM_V = KVBLK * 128 * 2, SHM_K = KVBLK * 64 * 2;
constexpr int LDS_BYTES = 2 * SHM_V + 2 * SHM_K + NW * 64 * 4;
constexpr float THRL = 11.5f;
#define DA_KSWZ(row, colB) ((row) * 128 + ((colB) ^ (((row) & 7) << 4)))
#define DA_SBAR() __builtin_amdgcn_sched_barrier(0)
__device__ __forceinline__ int v_st(int k, int c) { const int kk = (k & ~0xC) | ((k & 4) << 1) | ((k & 8) >> 1); return ((kk >> 3) * 4 + (c >> 5)) * 512 + ((kk & 7) * 32 + (c & 31)) * 2; }
__device__ __forceinline__ int v_rd_base(int lane) { return ((lane & 3) << 3) | (((lane >> 2) & 3) << 6) | (((lane >> 4) & 1) << 5) | (((lane >> 5) & 1) << 8); }
constexpr int v_rd_off(int d0, int ks, int half) { return d0 * 512 + ks * 4096 + half * 2048; }
__device__ __forceinline__ int crow(int r, int hi) { return (r & 3) + 8 * (r >> 2) + 4 * hi; }
__device__ __forceinline__ unsigned cvtpk(float lo, float hi) { unsigned r; asm volatile("v_cvt_pk_bf16_f32 %0, %1, %2" : "=v"(r) : "v"(lo), "v"(hi)); return r; }
__device__ __forceinline__ void mask_tile(f32x16& p0, f32x16& p1, int dq) {
    const float NEG = -__builtin_inff();
#pragma unroll
    for (int r = 0; r < 16; ++r) { const int c = (r & 3) + 8 * (r >> 2); if (dq - c < 0) p0[r] = NEG; if (dq - c - 32 < 0) p1[r] = NEG; }
}
__device__ __forceinline__ void partialSM(f32x16& p0, f32x16& p1, float& m_reg, float& mn, float& alpha) {
    float pmax = p0[0];
#pragma unroll
    for (int r = 1; r < 16; ++r) pmax = fmaxf(pmax, p0[r]);
#pragma unroll
    for (int r = 0; r < 16; ++r) pmax = fmaxf(pmax, p1[r]);
    { auto rr = __builtin_amdgcn_permlane32_swap(__float_as_uint(pmax), __float_as_uint(pmax), false, false); pmax = fmaxf(__uint_as_float(rr[0]), __uint_as_float(rr[1])); }
    if (__builtin_expect(__all((pmax - m_reg) <= THRL), 1)) { mn = m_reg; alpha = 1.f; }
    else { mn = fmaxf(m_reg, pmax); alpha = __builtin_amdgcn_exp2f(m_reg - mn); m_reg = mn; }
#pragma unroll
    for (int r = 0; r < 16; ++r) p0[r] = p0[r] - mn;
#pragma unroll
    for (int r = 0; r < 16; ++r) p1[r] = p1[r] - mn;
#pragma unroll
    for (int r = 0; r < 16; ++r) p0[r] = __builtin_amdgcn_exp2f(p0[r]);
}
__device__ __forceinline__ void finishSM(f32x16& p0, f32x16& p1, float alpha, float& l_reg, bf16x8& pa0, bf16x8& pa1, bf16x8& pa2, bf16x8& pa3) {
#pragma unroll
    for (int r = 0; r < 16; ++r) p1[r] = __builtin_amdgcn_exp2f(p1[r]);
    float ps = 0;
#pragma unroll
    for (int r = 0; r < 16; ++r) ps += p0[r];
#pragma unroll
    for (int r = 0; r < 16; ++r) ps += p1[r];
    { auto rr = __builtin_amdgcn_permlane32_swap(__float_as_uint(ps), __float_as_uint(ps), false, false); ps = __uint_as_float(rr[0]) + __uint_as_float(rr[1]); }
    l_reg = l_reg * alpha + ps;
#define DA_PK4(P, B_, OUT) do { unsigned a0 = cvtpk(P[B_+0], P[B_+1]), a1 = cvtpk(P[B_+2], P[B_+3]); unsigned b0 = cvtpk(P[B_+4], P[B_+5]), b1 = cvtpk(P[B_+6], P[B_+7]); \
        auto r0 = __builtin_amdgcn_permlane32_swap(a0, b0, false, false); auto r1 = __builtin_amdgcn_permlane32_swap(a1, b1, false, false); \
        u32x4 w = {r0[0], r1[0], r0[1], r1[1]}; OUT = *reinterpret_cast<bf16x8*>(&w); } while (0)
    DA_PK4(p0, 0, pa0); DA_PK4(p0, 8, pa1); DA_PK4(p1, 0, pa2); DA_PK4(p1, 8, pa3);
#undef DA_PK4
}
template <int KB>
__device__ __forceinline__ void qkt(f32x16& p0, f32x16& p1, const char* K_lds, int r32, int hi, const bf16x8* qr) {
    p0 = f32x16{}; p1 = f32x16{};
#pragma unroll
    for (int d0 = 0; d0 < 4; ++d0) { const char* a = K_lds + KB * SHM_K + DA_KSWZ(r32, (d0 * 16 + hi * 8) * 2);
        bf16x8 b0 = *reinterpret_cast<const bf16x8*>(a);
        bf16x8 b1 = *reinterpret_cast<const bf16x8*>(a + 32 * 128);
        p0 = __builtin_amdgcn_mfma_f32_32x32x16_bf16(b0, qr[d0], p0, 0, 0, 0);
        p1 = __builtin_amdgcn_mfma_f32_32x32x16_bf16(b1, qr[d0], p1, 0, 0, 0); }
}
template <int VB>
__device__ __forceinline__ void pv_tile(f32x16* o, int vb0, bf16x8 pa0, bf16x8 pa1, bf16x8 pa2, bf16x8 pa3) {
#define DA_TRRD(dst, off) asm volatile("ds_read_b64_tr_b16 %0, %1 offset:%2" : "=&v"(dst) : "v"(vb0), "i"(off) : "memory")
#define DA_PV_D0(d0) do { s16x4 l0, l1, l2, l3, h0, h1, h2, h3; constexpr int b_ = VB * SHM_V + v_rd_off(d0, 0, 0); \
        DA_TRRD(l0, b_); DA_TRRD(h0, b_ + 2048); DA_TRRD(l1, b_ + 4096); DA_TRRD(h1, b_ + 6144); DA_TRRD(l2, b_ + 8192); DA_TRRD(h2, b_ + 10240); DA_TRRD(l3, b_ + 12288); DA_TRRD(h3, b_ + 14336); \
        asm volatile("s_waitcnt lgkmcnt(0)" ::: "memory"); DA_SBAR(); \
        o[d0] = __builtin_amdgcn_mfma_f32_32x32x16_bf16(pa0, (bf16x8){l0[0], l0[1], l0[2], l0[3], h0[0], h0[1], h0[2], h0[3]}, o[d0], 0, 0, 0); \
        o[d0] = __builtin_amdgcn_mfma_f32_32x32x16_bf16(pa1, (bf16x8){l1[0], l1[1], l1[2], l1[3], h1[0], h1[1], h1[2], h1[3]}, o[d0], 0, 0, 0); \
        o[d0] = __builtin_amdgcn_mfma_f32_32x32x16_bf16(pa2, (bf16x8){l2[0], l2[1], l2[2], l2[3], h2[0], h2[1], h2[2], h2[3]}, o[d0], 0, 0, 0); \
        o[d0] = __builtin_amdgcn_mfma_f32_32x32x16_bf16(pa3, (bf16x8){l3[0], l3[1], l3[2], l3[3], h3[0], h3[1], h3[2], h3[3]}, o[d0], 0, 0, 0); } while (0)
    DA_PV_D0(0); DA_PV_D0(1); DA_PV_D0(2); DA_PV_D0(3);
#undef DA_PV_D0
#undef DA_TRRD
}
struct BlockRef { const bf16* Q; const bf16* K; const bf16* V; bf16* O; int P0; };
struct Seam { bf16x8 qr[4]; bf16x8 st_v0, st_v1, st_k0; };
#define DA_VMW() asm volatile("s_waitcnt vmcnt(0)" ::: "memory")
#define DA_VMWN(n) asm volatile("s_waitcnt vmcnt(%0)" :: "i"(n) : "memory")
#define DA_SLOAD(Kp, Vp, k0) do { S.st_v0 = *(const bf16x8*)((Vp) + (size_t)((k0) + sr) * VP + sc); S.st_v1 = *(const bf16x8*)((Vp) + (size_t)((k0) + 32 + sr) * VP + sc); \
                                  S.st_k0 = *(const bf16x8*)((Kp) + (size_t)((k0) + kr) * KP + kc); } while (0)
#define DA_SWRITE_K(bf) do { *(bf16x8*)(K_lds + (bf) * SHM_K + kws) = S.st_k0; } while (0)
#define DA_SWRITE_V(bf) do { *(bf16x8*)(V_lds + (bf) * SHM_V + vst0) = S.st_v0; *(bf16x8*)(V_lds + (bf) * SHM_V + vst1) = S.st_v1; } while (0)
__device__ __forceinline__ void prime(const BlockRef& cur, char* lds, Seam& S) {
    int tid_ = threadIdx.x; asm volatile("" : "+v"(tid_)); const int tid = tid_, wid = __builtin_amdgcn_readfirstlane(tid >> 6), lane = tid & 63, r32 = lane & 31, hi = lane >> 5;
    const int sr = tid >> 4, sc = (tid & 15) * 8, kr = tid >> 3, kc = (tid & 7) * 8, kws = DA_KSWZ(kr, kc * 2); char* K_lds = lds + 2 * SHM_V;
#pragma unroll
    for (int d0 = 0; d0 < 4; ++d0) S.qr[d0] = *(const bf16x8*)(cur.Q + (size_t)(wid * QBLK + r32) * QP + d0 * 16 + hi * 8);
    DA_SLOAD(cur.K, cur.V, 0); DA_VMW(); DA_SWRITE_K(0);
    __syncthreads();
}
__device__ __forceinline__ void block(const BlockRef& cur, const BlockRef& nxt, char* lds, Seam& S) {
    int tid_ = threadIdx.x; asm volatile("" : "+v"(tid_)); const int tid = tid_, wid = __builtin_amdgcn_readfirstlane(tid >> 6), lane = tid & 63, r32 = lane & 31, hi = lane >> 5;
    const int NT = (cur.P0 + QB) / KVBLK;
    const int qlo = cur.P0 + wid * QBLK, qm = qlo + r32 - 4 * hi;
    char* V_lds = lds; char* K_lds = lds + 2 * SHM_V;
    float* wsf = (float*)(lds + 2 * SHM_V + 2 * SHM_K) + wid * 64; float* li_l = wsf, * al_l = wsf + 32;
    float m_reg = -1e30f, l_reg = 0; f32x16 o[4] = {};
    const int sr = tid >> 4, sc = (tid & 15) * 8, vst0 = v_st(sr, sc), vst1 = v_st(32 + sr, sc), kr = tid >> 3, kc = (tid & 7) * 8, kws = DA_KSWZ(kr, kc * 2);
    const int vb0 = (int)(uintptr_t)V_lds + v_rd_base(lane);
    const bf16* Kh = cur.K; const bf16* Vh = cur.V;
#define DA_RESC(a) do { if (__any((a) < 1.f)) { if (hi == 0) al_l[r32] = (a); asm volatile("s_waitcnt lgkmcnt(0)" ::: "memory"); \
                     _Pragma("unroll") for (int d_ = 0; d_ < 4; ++d_) _Pragma("unroll") for (int r = 0; r < 16; ++r) o[d_][r] *= al_l[crow(r, hi)]; } } while (0)
#define DA_KBASE(t) ((t) * KVBLK)
#define DA_MASKT(P0_, P1_, t) do { const int kb_ = DA_KBASE(t); if (kb_ + KVBLK - 1 > qlo) mask_tile(P0_, P1_, qm - kb_); } while (0)
    f32x16 pA0, pA1, pB0, pB1; float mnA, mnB, alA, alB; bf16x8 pa0, pa1, pa2, pa3;
    DA_SWRITE_V(0); DA_SBAR();
    DA_SLOAD(Kh, Vh, DA_KBASE(1));
    DA_SBAR(); qkt<0>(pA0, pA1, K_lds, r32, hi, S.qr);
    DA_MASKT(pA0, pA1, 0); partialSM(pA0, pA1, m_reg, mnA, alA);
    DA_VMW(); DA_SWRITE_V(1); DA_SWRITE_K(1);
    __syncthreads();
#define DA_HALF_STEP(PX0, PX1, mnX, alX, PY0, PY1, alY, t, KB, VB, SB) do { \
        DA_SBAR(); qkt<KB>(PX0, PX1, K_lds, r32, hi, S.qr); \
        finishSM(PY0, PY1, alY, l_reg, pa0, pa1, pa2, pa3); DA_SBAR(); \
        if ((t) + 1 < NT) { DA_SLOAD(Kh, Vh, DA_KBASE((t) + 1)); DA_SBAR(); } \
        pv_tile<VB>(o, vb0, pa0, pa1, pa2, pa3); DA_MASKT(PX0, PX1, (t)); partialSM(PX0, PX1, m_reg, mnX, alX); \
        __syncthreads(); \
        if ((t) + 1 < NT) { DA_VMW(); DA_SWRITE_V(SB); DA_SWRITE_K(SB); } \
        DA_RESC(alX); __syncthreads(); } while (0)
    for (int t = 1; t + 1 < NT; t += 2) {
        DA_HALF_STEP(pB0, pB1, mnB, alB, pA0, pA1, alA, t, 1, 0, 0);
        DA_HALF_STEP(pA0, pA1, mnA, alA, pB0, pB1, alB, t + 1, 0, 1, 1);
    }
    DA_SBAR(); qkt<1>(pB0, pB1, K_lds, r32, hi, S.qr); DA_SBAR();
    DA_SLOAD(nxt.K, nxt.V, 0); DA_SBAR();
#pragma unroll
    for (int d0 = 0; d0 < 4; ++d0) S.qr[d0] = *(const bf16x8*)(nxt.Q + (size_t)(wid * QBLK + r32) * QP + d0 * 16 + hi * 8);
    DA_SBAR();
    finishSM(pA0, pA1, alA, l_reg, pa0, pa1, pa2, pa3); DA_SBAR();
    pv_tile<0>(o, vb0, pa0, pa1, pa2, pa3);
    DA_MASKT(pB0, pB1, NT - 1); partialSM(pB0, pB1, m_reg, mnB, alB); __syncthreads(); DA_RESC(alB);
    finishSM(pB0, pB1, alB, l_reg, pa0, pa1, pa2, pa3); DA_SBAR(); pv_tile<1>(o, vb0, pa0, pa1, pa2, pa3);
    DA_SBAR(); DA_VMWN(4); DA_SWRITE_K(0); DA_SBAR();
    if (hi == 0) li_l[r32] = l_reg; asm volatile("s_waitcnt lgkmcnt(0)" ::: "memory");
    float rli[16];
#pragma unroll
    for (int r = 0; r < 16; ++r) rli[r] = __builtin_amdgcn_rcpf(li_l[crow(r, hi)]);
    bf16* Ow = cur.O + (size_t)(wid * QBLK) * OP;
#pragma unroll
    for (int r = 0; r < 16; ++r) { const int orow = crow(r, hi);
#pragma unroll
        for (int d0 = 0; d0 < 4; ++d0) { const float v = o[d0][r] * rli[r]; const float vn = __shfl_xor(v, 1);
            if ((r32 & 1) == 0) *(unsigned*)(Ow + (size_t)orow * OP + d0 * 32 + r32) = cvtpk(v, vn); } }
    __syncthreads();
#undef DA_RESC
#undef DA_KBASE
#undef DA_MASKT
#undef DA_HALF_STEP
}
#undef DA_VMW
#undef DA_VMWN
#undef DA_SLOAD
#undef DA_SWRITE_K
#undef DA_SWRITE_V
#undef DA_KSWZ
#undef DA_SBAR
}
namespace cg = cooperative_groups;
#define LAS __attribute__((address_space(3)))
typedef unsigned short bf16;
typedef unsigned v4u __attribute__((ext_vector_type(4)));
typedef unsigned v2u __attribute__((ext_vector_type(2)));
typedef float f32x4 __attribute__((ext_vector_type(4)));
typedef float f32x2 __attribute__((ext_vector_type(2)));
typedef short bf16x8 __attribute__((ext_vector_type(8)));

constexpr int NWAVES = 8, NTHREADS = 512;
constexpr int BATCH = 4, SEQ = 4096, DM = 1024, M = BATCH * SEQ, DI = 2048;
constexpr float EPS = 1e-6f;
constexpr size_t MiB = 1u << 20;
constexpr size_t WS_MOD = 0;
constexpr size_t WS_BAR = 512 * 1024, WS_BAR_BYTES = 16384;
constexpr size_t WS_WGT = 256 * 1024;
constexpr size_t WS_W0T = 1 * MiB;
constexpr size_t WS_WO0T = 17 * MiB;
constexpr size_t WS_W1T = 21 * MiB;
constexpr size_t WS_WO1T = 33 * MiB;
constexpr size_t WS_ROPE = 37 * MiB;
constexpr size_t WS_DEC = 37 * MiB;
constexpr size_t WS_SSP = 41 * MiB;
constexpr size_t WS_ATTN = 1 * MiB;
constexpr size_t WS_Q = 64 * MiB, WS_K = 128 * MiB, WS_V = 192 * MiB;
constexpr size_t WS_Q1 = 64 * MiB, WS_K1 = 96 * MiB;
constexpr size_t WS_H1 = 128 * MiB, WS_KET = 160 * MiB;
constexpr size_t WS_V1 = 192 * MiB;
constexpr size_t WS_END = 256 * MiB;
constexpr size_t OUT_H0 = 0;
constexpr size_t OUT_OSC = 32 * MiB;
constexpr int LDS_BYTES = 147456;

#define LDS_WAIT() asm volatile("s_waitcnt lgkmcnt(0)" ::: "memory")
#define LBAR() do { asm volatile("s_waitcnt lgkmcnt(0)" ::: "memory"); __builtin_amdgcn_s_barrier(); asm volatile("" ::: "memory"); } while (0)
#define VM_WAIT() asm volatile("s_waitcnt vmcnt(0)" ::: "memory")
__device__ __forceinline__ unsigned f2bf(float f) { unsigned u = __builtin_bit_cast(unsigned, f); return (u + 0x7fffu + ((u >> 16) & 1u)) >> 16; }
__device__ __forceinline__ unsigned pk2(float lo, float hi) { return f2bf(lo) | (f2bf(hi) << 16); }
__device__ __forceinline__ float bflo(unsigned w) { return __builtin_bit_cast(float, w << 16); }
__device__ __forceinline__ float bfhi(unsigned w) { return __builtin_bit_cast(float, w & 0xffff0000u); }
__device__ __forceinline__ float silu_f(float z) { return z * __builtin_amdgcn_rcpf(1.0f + __builtin_amdgcn_exp2f(-1.4426950408889634f * z)); }
__device__ __forceinline__ float wave_sum(float v) {
#pragma unroll
    for (int o = 1; o < 64; o <<= 1) v += __shfl_xor(v, o);
    return v;
}

struct Args { const void* in[19]; float* out; unsigned char* ws; };

#define XB_TMO      128
#define XB_XCNT(j)  (256  + 64 * (j))
#define XB_XSUB(j)  (1280 + 64 * (j))
#define XB_XGEN(j)  (2304 + 64 * (j))
#define XB_TOP      3328
#define XB_TOPGEN   3392
#define XCD_BAR_WORDS 3456
#define XB_SPIN_CAP (1u << 18)

__device__ __forceinline__ unsigned xb_ld(unsigned* p)              { return __hip_atomic_load(p, __ATOMIC_RELAXED, __HIP_MEMORY_SCOPE_AGENT); }
__device__ __forceinline__ unsigned xb_add(unsigned* p, unsigned v) { return __hip_atomic_fetch_add(p, v, __ATOMIC_RELAXED, __HIP_MEMORY_SCOPE_AGENT); }
__device__ __forceinline__ unsigned xb_xcc_id() { return (unsigned)__builtin_amdgcn_s_getreg((3 << 11) | 20) & 0xFu; }
#define XB_SPIN(cond, bar) do { unsigned _sp = 0; while (cond) { __builtin_amdgcn_s_sleep(1); \
    if ((++_sp & 255u) == 0u) { if (xb_ld(&(bar)[XB_TMO])) break; if (_sp > XB_SPIN_CAP) { atomicAdd(&(bar)[XB_TMO], 1u); break; } } } } while (0)

struct XcdBarrier {
    unsigned* bar; unsigned x;
    volatile LAS unsigned* st;
};

__device__ __forceinline__ XcdBarrier xcd_barrier_post(unsigned* bar, volatile LAS unsigned* st) {
    XcdBarrier b; b.bar = bar; b.x = xb_xcc_id(); b.st = st;
    if (threadIdx.x == 0) (void)xb_add(&bar[XB_XCNT(b.x)], 1u);
    return b;
}
__device__ __forceinline__ void xcd_barrier_complete(unsigned* bar, unsigned x, unsigned& nloc, unsigned& nx) {
    const unsigned G = gridDim.x * gridDim.y * gridDim.z;
    unsigned sum, cnt, mine, sp = 0u;
    for (;;) {
        sum = 0u; cnt = 0u; mine = 0u;
#pragma unroll
        for (unsigned j = 0; j < 16; ++j) { const unsigned c = xb_ld(&bar[XB_XCNT(j)]); sum += c; cnt += (c > 0u) ? 1u : 0u; mine = (j == x) ? c : mine; }
        if (sum == G) break;
        __builtin_amdgcn_s_sleep(1);
        if ((++sp & 255u) == 0u) { if (xb_ld(&bar[XB_TMO])) break; if (sp > XB_SPIN_CAP) { atomicAdd(&bar[XB_TMO], 1u); break; } }
    }
    nloc = mine > 0u ? mine : 1u; nx = cnt > 0u ? cnt : 1u;
}

__device__ __forceinline__ void xcd_barrier(const XcdBarrier& b) {
    asm volatile("s_waitcnt vmcnt(0)" ::: "memory");
    __syncthreads();
    if (threadIdx.x == 0) {
        unsigned* bar = b.bar;
        __builtin_amdgcn_s_waitcnt(0);
        unsigned nloc = b.st[0], nx = b.st[1];
        if (nloc == 0u) { xcd_barrier_complete(bar, b.x, nloc, nx); b.st[0] = nloc; b.st[1] = nx; }
        const unsigned old = xb_add(&bar[XB_XSUB(b.x)], 1u);
        const unsigned gen = old / nloc;
        if (old + 1u == (gen + 1u) * nloc) {
            __builtin_amdgcn_fence(__ATOMIC_RELEASE, "agent");
            asm volatile("s_waitcnt vmcnt(0)" ::: "memory");
            const unsigned og = xb_add(&bar[XB_TOP], 1u);
            const unsigned tg = og / nx;
            if (og + 1u == (tg + 1u) * nx) xb_add(&bar[XB_TOPGEN], 1u);
            else XB_SPIN(xb_ld(&bar[XB_TOPGEN]) == tg, bar);
            __builtin_amdgcn_fence(__ATOMIC_ACQUIRE, "agent");
            xb_add(&bar[XB_XGEN(b.x)], 1u);
            asm volatile("s_waitcnt vmcnt(0)" ::: "memory");
        } else {
            XB_SPIN(xb_ld(&bar[XB_XGEN(b.x)]) == gen, bar);
            __builtin_amdgcn_fence(__ATOMIC_ACQUIRE, "agent");
            asm volatile("s_waitcnt vmcnt(0)" ::: "memory");
        }
    }
    __syncthreads();
}

struct EpiQKV0 {
    static constexpr bool PERM = true, AFTER_DRAIN = false;
    bf16* Q; bf16* K; bf16* V; const float* rope;
    __device__ __forceinline__ void operator()(const pg8::f32x4 (&acc)[2][2][4][2], const pg8::Unit& u, int wr, int wc, int fr, int fq) const {
        const int row0 = u.pm * 256 + wr * 64 + fr; const int colt = u.pn * 256; const int t = colt >> 11;
        const int cr0 = (colt & 2047) + wc * 32 + 8 * fq;
        bf16* base = Q + (size_t)t * (size_t)(32u << 20);
        if (t < 2) {
            const int g4 = 4 * (4 * (wc & 1) + fq);
            const float sc = t == 0 ? 0.125f * 1.4426950408889634f : 1.0f;
#pragma unroll
            for (int ai = 0; ai < 2; ++ai)
#pragma unroll
                for (int m = 0; m < 4; ++m) {
                    const int row = row0 + ai * 128 + m * 16;
                    const f32x4 cs0 = *(const f32x4*)(rope + ((size_t)row * 32 + g4) * 2), cs1 = *(const f32x4*)(rope + ((size_t)row * 32 + g4) * 2 + 4);
                    const float c0 = cs0[0] * sc, s0 = cs0[1] * sc, c1 = cs0[2] * sc, s1 = cs0[3] * sc, c2 = cs1[0] * sc, s2 = cs1[1] * sc, c3 = cs1[2] * sc, s3 = cs1[3] * sc;
                    bf16* rowp = base + (size_t)row * 2048 + cr0;
#pragma unroll
                    for (int bj = 0; bj < 2; ++bj) {
                        const pg8::f32x4 a = acc[ai][bj][m][0], b = acc[ai][bj][m][1];
                        v4u w;
                        w.x = pk2(a[0] * c0 - b[0] * s0, a[1] * c1 - b[1] * s1); w.y = pk2(a[2] * c2 - b[2] * s2, a[3] * c3 - b[3] * s3);
                        w.z = pk2(b[0] * c0 + a[0] * s0, b[1] * c1 + a[1] * s1); w.w = pk2(b[2] * c2 + a[2] * s2, b[3] * c3 + a[3] * s3);
                        *(v4u*)(rowp + bj * 128) = w;
                    }
                }
        } else {
#pragma unroll
            for (int ai = 0; ai < 2; ++ai)
#pragma unroll
                for (int m = 0; m < 4; ++m) {
                    bf16* rowp = base + (size_t)(row0 + ai * 128 + m * 16) * 2048 + cr0;
#pragma unroll
                    for (int bj = 0; bj < 2; ++bj) {
                        const pg8::f32x4 a = acc[ai][bj][m][0], b = acc[ai][bj][m][1];
                        v4u w; w.x = pk2(a[0], a[1]); w.y = pk2(a[2], a[3]); w.z = pk2(b[0], b[1]); w.w = pk2(b[2], b[3]);
                        *(v4u*)(rowp + bj * 128) = w;
                    }
                }
        }
    }
};
struct EpiQKV1 {
    static constexpr bool PERM = true, AFTER_DRAIN = false;
    bf16* Q; bf16* K; bf16* V;
    __device__ __forceinline__ void operator()(const pg8::f32x4 (&acc)[2][2][4][2], const pg8::Unit& u, int wr, int wc, int fr, int fq) const {
        const int row0 = u.pm * 256 + wr * 64 + fr; const int colt = u.pn * 256;
        bf16* base; int pitch, c0;
        if (colt < 2048) { base = Q + (size_t)(colt >> 10) * (size_t)(16u << 20); pitch = 1024; c0 = colt & 1023; } else { base = V; pitch = 2048; c0 = colt - 2048; }
        c0 += wc * 32 + 8 * fq;
#pragma unroll
        for (int ai = 0; ai < 2; ++ai)
#pragma unroll
            for (int m = 0; m < 4; ++m) {
                bf16* rowp = base + (size_t)(row0 + ai * 128 + m * 16) * pitch + c0;
#pragma unroll
                for (int bj = 0; bj < 2; ++bj) {
                    const pg8::f32x4 a = acc[ai][bj][m][0], b = acc[ai][bj][m][1];
                    v4u w; w.x = pk2(a[0], a[1]); w.y = pk2(a[2], a[3]); w.z = pk2(b[0], b[1]); w.w = pk2(b[2], b[3]);
                    *(v4u*)(rowp + bj * 128) = w;
                }
            }
    }
};
template <bool NORM> struct EpiGate {
    static constexpr bool PERM = true, AFTER_DRAIN = false;
    bf16* G; const float* rstd; const float* nw; bool dry;
    __device__ __forceinline__ void operator()(const pg8::f32x4 (&acc)[2][2][4][2], const pg8::Unit& u, int wr, int wc, int fr, int fq) const {
        const int row0 = u.pm * 256 + wr * 64 + fr; const int c0 = u.pn * 256 + wc * 32 + 8 * fq;
        f32x4 wv[2][2];
        if (NORM) {
#pragma unroll
            for (int bj = 0; bj < 2; ++bj) { wv[bj][0] = *(const f32x4*)(nw + ((c0 + bj * 128) & 511)); wv[bj][1] = *(const f32x4*)(nw + ((c0 + bj * 128) & 511) + 4); }
        }
#pragma unroll
        for (int ai = 0; ai < 2; ++ai)
#pragma unroll
            for (int m = 0; m < 4; ++m) {
                const int row = row0 + ai * 128 + m * 16;
                bf16* rowp = G + (size_t)row * 2048 + c0;
                float rs = 1.0f;
                if (NORM) { const f32x4* sp = (const f32x4*)(rstd + ((size_t)row * 4 + (c0 >> 9)) * 32); f32x4 a4 = sp[0];
#pragma unroll
                    for (int q = 1; q < 8; ++q) a4 += sp[q];
                    rs = 1.0f / sqrtf(((a4[0] + a4[1]) + (a4[2] + a4[3])) * (1.0f / 512.0f) + EPS); }
#pragma unroll
                for (int bj = 0; bj < 2; ++bj) {
                    const pg8::f32x4 a = acc[ai][bj][m][0], b = acc[ai][bj][m][1];
                    const v4u on = *(const v4u*)(rowp + bj * 128);
                    float o[8] = {bflo(on.x), bfhi(on.x), bflo(on.y), bfhi(on.y), bflo(on.z), bfhi(on.z), bflo(on.w), bfhi(on.w)};
                    if (NORM) {
#pragma unroll
                        for (int i = 0; i < 4; ++i) { o[i] *= rs * wv[bj][0][i]; o[4 + i] *= rs * wv[bj][1][i]; }
                    }
                    v4u w;
                    w.x = pk2(o[0] * silu_f(a[0]), o[1] * silu_f(a[1])); w.y = pk2(o[2] * silu_f(a[2]), o[3] * silu_f(a[3]));
                    w.z = pk2(o[4] * silu_f(b[0]), o[5] * silu_f(b[1])); w.w = pk2(o[6] * silu_f(b[2]), o[7] * silu_f(b[3]));
                    if (!dry) *(v4u*)(rowp + bj * 128) = w;
                }
            }
    }
};
struct EpiRes {
    static constexpr bool PERM = true, AFTER_DRAIN = false;
    const float* xin; float* xout; const float* gate; bool dry;
    __device__ __forceinline__ void operator()(const pg8::f32x4 (&acc)[2][2][4][2], const pg8::Unit& u, int wr, int wc, int fr, int fq) const {
        const int row0 = u.pm * 256 + wr * 64 + fr; const int c0 = u.pn * 256 + wc * 32 + 8 * fq; const int b = u.pm >> 4;
        f32x4 gv[2][2];
#pragma unroll
        for (int bj = 0; bj < 2; ++bj) { gv[bj][0] = *(const f32x4*)(gate + b * 3072 + c0 + bj * 128); gv[bj][1] = *(const f32x4*)(gate + b * 3072 + c0 + bj * 128 + 4); }
#pragma unroll
        for (int ai = 0; ai < 2; ++ai)
#pragma unroll
            for (int m = 0; m < 4; ++m) {
                const size_t off = (size_t)(row0 + ai * 128 + m * 16) * 1024 + c0;
#pragma unroll
                for (int bj = 0; bj < 2; ++bj) {
                    const f32x4 x0 = *(const f32x4*)(xin + off + bj * 128), x1 = *(const f32x4*)(xin + off + bj * 128 + 4);
                    const pg8::f32x4 a = acc[ai][bj][m][0], b2 = acc[ai][bj][m][1];
                    f32x4 o0, o1;
#pragma unroll
                    for (int i = 0; i < 4; ++i) { o0[i] = x0[i] + gv[bj][0][i] * a[i]; o1[i] = x1[i] + gv[bj][1][i] * b2[i]; }
                    if (!dry) { *(f32x4*)(xout + off + bj * 128) = o0; *(f32x4*)(xout + off + bj * 128 + 4) = o1; }
                }
            }
    }
};

template <int MODE> __device__ __forceinline__ int dest_row(int n) {
    if (MODE == 1 && n < 4096) { const int d = n & 63, dp = d & 31; return (n & ~63) + 8 * (dp >> 2) + 4 * (d >> 5) + (dp & 3); }
    return n;
}
template <int MODE> __device__ __forceinline__ void p0_transpose_item(const float* W, int ld, int K, bf16* WT, int nblk, LAS float* scr, int item, int lane) {
    const int kb = item / nblk, nb = item % nblk, k0 = 64 * kb, n0 = 32 * nb;
#pragma unroll 8
    for (int i = 0; i < 32; ++i) { const int kk = 2 * i + (lane >> 5); scr[kk * 33 + (lane & 31)] = W[(size_t)(k0 + kk) * ld + n0 + (lane & 31)]; }
    LDS_WAIT(); asm volatile("" ::: "memory");
    const int c = lane & 7;
#pragma unroll
    for (int j = 0; j < 4; ++j) { const int n = (lane >> 3) + 8 * j; const LAS float* s = scr + (8 * c) * 33 + n;
        v4u o; o.x = pk2(s[0 * 33], s[1 * 33]); o.y = pk2(s[2 * 33], s[3 * 33]); o.z = pk2(s[4 * 33], s[5 * 33]); o.w = pk2(s[6 * 33], s[7 * 33]);
        *(v4u*)(WT + (size_t)dest_row<MODE>(n0 + n) * K + k0 + 8 * c) = o; }
    LDS_WAIT(); asm volatile("" ::: "memory");
}
__device__ __forceinline__ void norm_row_mod(const float* xrow, const float* g, const float* modb, bf16* orow, int lane) {
    const f32x4* xr = (const f32x4*)xrow + lane;
    f32x4 v[4]; float s = 0.f;
#pragma unroll
    for (int j = 0; j < 4; ++j) { v[j] = xr[64 * j]; s += (v[j][0] * v[j][0] + v[j][1] * v[j][1]) + (v[j][2] * v[j][2] + v[j][3] * v[j][3]); }
    const float rstd = 1.0f / sqrtf(wave_sum(s) * (1.0f / DM) + EPS);
    unsigned long long* o8 = (unsigned long long*)orow + lane;
#pragma unroll
    for (int j = 0; j < 4; ++j) {
        const f32x4 gg = ((const f32x4*)g)[lane + 64 * j], sh = ((const f32x4*)modb)[lane + 64 * j], sc = ((const f32x4*)(modb + 1024))[lane + 64 * j];
        float y[4];
#pragma unroll
        for (int i = 0; i < 4; ++i) y[i] = v[j][i] * rstd * gg[i] * (1.0f + sc[i]) + sh[i];
        o8[64 * j] = (unsigned long long)pk2(y[0], y[1]) | ((unsigned long long)pk2(y[2], y[3]) << 32);
    }
}

__device__ __forceinline__ pg8::f32x4 mfma16(bf16x8 a, bf16x8 b, pg8::f32x4 c) { return __builtin_amdgcn_mfma_f32_16x16x32_bf16(a, b, c, 0, 0, 0); }

#ifndef STOP_AFTER
#define STOP_AFTER 99
#endif
#ifndef DUP_PHASE
#define DUP_PHASE -1
#endif
#ifndef DUP_N
#define DUP_N 2
#endif
#define PHASE_LOOP(k) for (int rep_ = 0; rep_ < ((DUP_PHASE == (k)) ? DUP_N : 1); ++rep_)
#define DRY(k) (DUP_PHASE == (k) && rep_ > 0)

__global__ void __launch_bounds__(NTHREADS, 2) fwd_mega(Args args) {
    extern __shared__ __attribute__((aligned(16))) unsigned char lds_raw[];
    cg::grid_group grid = cg::this_grid();
    LAS unsigned char* lds = (LAS unsigned char*)lds_raw;
    const int G = gridDim.x, bx = blockIdx.x;
    const int vcu = (G % 8 == 0) ? (bx % 8) * (G / 8) + bx / 8 : bx;
    const int NGW = G * NWAVES;
#define FRESH_IDS() int tid_ = threadIdx.x; asm volatile("" : "+v"(tid_)); const int tid = tid_, lane = tid & 63, wid = __builtin_amdgcn_readfirstlane(tid >> 6), gw = bx * NWAVES + wid; (void)gw; (void)lane; (void)tid
    unsigned char* ws = args.ws;
    unsigned char* outb = (unsigned char*)args.out;
    if (ws == nullptr) grid.sync();
    volatile LAS unsigned* bst = (volatile LAS unsigned*)(lds + LDS_BYTES - 64);
    if (threadIdx.x < 2) bst[threadIdx.x] = 0u;
    __syncthreads();
    const XcdBarrier gbar = xcd_barrier_post((unsigned*)(ws + WS_BAR), bst);
#define GSYNC() xcd_barrier(gbar)
    const float* x = (const float*)args.in[0];
    const float* cvec = (const float*)args.in[1];
    const int* positions = (const int*)args.in[2];
    const float* ada_w = (const float*)args.in[3];
    const float* ada_b = (const float*)args.in[4];
    const float* norm_g = (const float*)args.in[5];
    const float* da_w_in = (const float*)args.in[6];
    const float* lq1 = (const float*)args.in[7];
    const float* lk1 = (const float*)args.in[8];
    const float* lq2 = (const float*)args.in[9];
    const float* lk2 = (const float*)args.in[10];
    const float* subln_w = (const float*)args.in[11];
    const float* da_w_out = (const float*)args.in[12];
    const float* gla_w_in = (const float*)args.in[13];
    const float* gla_w_gate_up = (const float*)args.in[14];
    const float* gla_b_gate = (const float*)args.in[15];
    const float* gla_norm_w = (const float*)args.in[16];
    const float* gla_w_out = (const float*)args.in[17];
    const float* final_g = (const float*)args.in[18];
    float* mod = (float*)(ws + WS_MOD);
    bf16* WgT = (bf16*)(ws + WS_WGT);
    bf16* W0t = (bf16*)(ws + WS_W0T); bf16* Wo0t = (bf16*)(ws + WS_WO0T); bf16* W1t = (bf16*)(ws + WS_W1T); bf16* Wo1t = (bf16*)(ws + WS_WO1T);
    float* rope = (float*)(ws + WS_ROPE);
    bf16* H0 = (bf16*)(outb + OUT_H0);
    bf16* Qb = (bf16*)(ws + WS_Q); bf16* Kb = (bf16*)(ws + WS_K); bf16* Vb = (bf16*)(ws + WS_V);

    {
        FRESH_IDS();
        LAS float* red = (LAS float*)lds;
        for (int item = bx; item < 96; item += G) {
            const int layer = item / 48, cgp = item % 48;
            const float* W = ada_w + (size_t)layer * 1024 * 3072 + cgp * 64 + lane;
            float a0 = 0.f, a1 = 0.f, a2 = 0.f, a3 = 0.f;
#pragma unroll 8
            for (int k = 128 * wid; k < 128 * wid + 128; ++k) {
                const float w = W[(size_t)k * 3072];
                a0 += cvec[k] * w; a1 += cvec[1024 + k] * w; a2 += cvec[2048 + k] * w; a3 += cvec[3072 + k] * w;
            }
            red[(wid * 4 + 0) * 64 + lane] = a0; red[(wid * 4 + 1) * 64 + lane] = a1; red[(wid * 4 + 2) * 64 + lane] = a2; red[(wid * 4 + 3) * 64 + lane] = a3;
            __syncthreads();
            if (tid < 256) {
                const int b = tid >> 6; float s = 0.f;
#pragma unroll
                for (int w = 0; w < 8; ++w) s += red[(w * 4 + b) * 64 + lane];
                mod[(size_t)(layer * 4 + b) * 3072 + cgp * 64 + lane] = s + ada_b[layer * 3072 + cgp * 64 + lane];
            }
            __syncthreads();
        }
        LAS float* scr = (LAS float*)(lds + wid * 16384);
        constexpr int I_W0 = 16 * 256, I_W1 = 16 * 192, I_WO = 32 * 32, NITEMS = I_W0 + I_W1 + 2 * I_WO;
        for (int it = gw; it < NITEMS; it += NGW) {
            int r = it;
            if (r < I_W0) { p0_transpose_item<1>(da_w_in, 8192, 1024, W0t, 256, scr, r, lane); continue; } r -= I_W0;
            if (r < I_W1) { p0_transpose_item<0>(gla_w_in, 6160, 1024, W1t, 192, scr, r, lane); continue; } r -= I_W1;
            if (r < I_WO) { p0_transpose_item<0>(da_w_out, 1024, 2048, Wo0t, 32, scr, r, lane); continue; } r -= I_WO;
            p0_transpose_item<0>(gla_w_out, 1024, 2048, Wo1t, 32, scr, r, lane);
        }
        const int gt = bx * NTHREADS + tid, NGT = G * NTHREADS;
        for (int id = gt; id < 16 * 1024; id += NGT) { const int r = id & 15, k = id >> 4; WgT[r * 1024 + k] = (bf16)f2bf(gla_w_in[(size_t)k * 6160 + 6144 + r]); }
        for (int id = gt; id < M * 32; id += NGT) {
            const int row = id >> 5, i = id & 31;
            const float inv = __builtin_amdgcn_exp2f(-(float)i * (13.287712379549449f / 32.0f));
            const float ang = (float)positions[row] * inv;
            const double t = (double)ang * 0.15915494309189535; const float frc = (float)(t - __builtin_rint(t));
            f32x2 cs; cs[0] = __builtin_amdgcn_cosf(frc); cs[1] = __builtin_amdgcn_sinf(frc);
            *(f32x2*)(rope + (size_t)id * 2) = cs;
        }
    }
    GSYNC();
    PHASE_LOOP(0) { FRESH_IDS(); for (int m = gw; m < M; m += NGW) norm_row_mod(x + (size_t)m * DM, norm_g, mod + (size_t)(m >> 12) * 3072, H0 + (size_t)m * DM, lane);
    GSYNC(); }
#if STOP_AFTER >= 1
    PHASE_LOOP(1) {
        pg8::Gemm g{H0, W0t, M, 6144, 1024}; pg8::StaticOrder S; S.init(M, 6144, G, bx);
        EpiQKV0 E{Qb, Kb, Vb, rope};
        pg8::gemm_phase<EpiQKV0, pg8::StaticOrder, true, true>(lds, g, S, E);
    GSYNC(); }
    PHASE_LOOP(2) {
        float lam;
        { FRESH_IDS(); const float p1 = wave_sum(lq1[lane] * lk1[lane]), p2 = wave_sum(lq2[lane] * lk2[lane]); lam = __builtin_bit_cast(float, __builtin_amdgcn_readfirstlane(__builtin_bit_cast(int, __expf(p1) - __expf(p2) + 0.2f))); }
        bf16* Osc = (bf16*)(outb + OUT_OSC + (size_t)bx * 131072);
        for (int v = vcu; v < 256; v += G) {
            const int bh = v >> 2, b = bh >> 4, h16 = bh & 15, s = v & 3;
#define DA_REF(R, idx_) do { const int gi_ = (idx_) >> 1, mp_ = (idx_) & 1; const int qb_ = (gi_ >> 1) * 8 + ((gi_ & 1) ? 7 - s : s); \
                const size_t row0_ = (size_t)b * SEQ + (size_t)qb_ * 256; const int h32_ = 2 * h16 + mp_; \
                R.Q = Qb + row0_ * 2048 + h32_ * 64; R.K = Kb + (size_t)b * SEQ * 2048 + h32_ * 64; R.V = Vb + (size_t)b * SEQ * 2048 + h16 * 128; R.O = Osc + mp_ * 32768; R.P0 = qb_ * 256; } while (0)
            da::BlockRef cur, nxt; da::Seam S;
            DA_REF(cur, 0);
            da::prime(cur, (char*)lds_raw, S);
            for (int idx = 0; idx < 8; ++idx) {
                const int nidx = idx + 1 < 8 ? idx + 1 : idx;
                DA_REF(nxt, nidx);
                da::block(cur, nxt, (char*)lds_raw, S);
                if (idx & 1) {
                    VM_WAIT(); __syncthreads(); __builtin_amdgcn_fence(__ATOMIC_ACQUIRE, "agent");
                    FRESH_IDS();
                    const int gi = idx >> 1, qb = (gi >> 1) * 8 + ((gi & 1) ? 7 - s : s);
                    const size_t row0 = (size_t)b * SEQ + (size_t)qb * 256;
                    const int row = tid >> 1, vh = tid & 1;
                    const bf16* p0 = Osc + row * 128 + vh * 64; const bf16* p1 = Osc + 32768 + row * 128 + vh * 64;
                    float d[64]; float ss = 0.f;
#pragma unroll
                    for (int c8 = 0; c8 < 8; ++c8) {
                        const v4u a = *(const v4u*)(p0 + 8 * c8), bq = *(const v4u*)(p1 + 8 * c8);
                        d[8 * c8 + 0] = bflo(a.x) - lam * bflo(bq.x); d[8 * c8 + 1] = bfhi(a.x) - lam * bfhi(bq.x);
                        d[8 * c8 + 2] = bflo(a.y) - lam * bflo(bq.y); d[8 * c8 + 3] = bfhi(a.y) - lam * bfhi(bq.y);
                        d[8 * c8 + 4] = bflo(a.z) - lam * bflo(bq.z); d[8 * c8 + 5] = bfhi(a.z) - lam * bfhi(bq.z);
                        d[8 * c8 + 6] = bflo(a.w) - lam * bflo(bq.w); d[8 * c8 + 7] = bfhi(a.w) - lam * bfhi(bq.w);
                    }
#pragma unroll
                    for (int i = 0; i < 64; ++i) ss += d[i] * d[i];
                    ss += __shfl_xor(ss, 1);
                    const float rs = 0.8f / sqrtf(ss * (1.0f / 128.0f) + EPS);
                    bf16* op = Qb + (row0 + row) * 2048 + h16 * 128 + vh * 64;
#pragma unroll
                    for (int c8 = 0; c8 < 8; ++c8) {
                        const f32x4 w0 = *(const f32x4*)(subln_w + vh * 64 + 8 * c8), w1 = *(const f32x4*)(subln_w + vh * 64 + 8 * c8 + 4);
                        v4u w;
                        w.x = pk2(d[8 * c8 + 0] * rs * w0[0], d[8 * c8 + 1] * rs * w0[1]); w.y = pk2(d[8 * c8 + 2] * rs * w0[2], d[8 * c8 + 3] * rs * w0[3]);
                        w.z = pk2(d[8 * c8 + 4] * rs * w1[0], d[8 * c8 + 5] * rs * w1[1]); w.w = pk2(d[8 * c8 + 6] * rs * w1[2], d[8 * c8 + 7] * rs * w1[3]);
                        if (!DRY(2)) *(v4u*)(op + 8 * c8) = w;
                    }
                }
                cur = nxt;
            }
#undef DA_REF
        }
    GSYNC(); }
    PHASE_LOOP(3) {
        pg8::Gemm g{H0, W0t + (size_t)6144 * 1024, M, 2048, 1024}; pg8::StaticOrder S; S.init(M, 2048, G, bx);
        EpiGate<false> E{Qb, nullptr, nullptr, DRY(3)};
        pg8::gemm_phase<EpiGate<false>, pg8::StaticOrder, true, true>(lds, g, S, E);
    GSYNC(); }
    PHASE_LOOP(4) {
        pg8::Gemm g{Qb, Wo0t, M, 1024, 2048}; pg8::StaticOrder S; S.init(M, 1024, G, bx);
        EpiRes E{x, args.out, mod + 2048, false};
        pg8::gemm_phase<EpiRes, pg8::StaticOrder, true, true>(lds, g, S, E);
    GSYNC(); }
#else
    { FRESH_IDS(); for (size_t i = (size_t)bx * NTHREADS + tid; i < (size_t)M * DM / 4; i += (size_t)G * NTHREADS) ((f32x4*)args.out)[i] = ((const f32x4*)x)[i]; }
    GSYNC();
#endif
#if STOP_AFTER >= 2
    bf16* H1 = (bf16*)(ws + WS_H1); bf16* Q1 = (bf16*)(ws + WS_Q1); bf16* K1 = (bf16*)(ws + WS_K1); bf16* V1 = (bf16*)(ws + WS_V1); bf16* keT = (bf16*)(ws + WS_KET);
    bf16* attnb = (bf16*)(ws + WS_ATTN); float* decb = (float*)(ws + WS_DEC); float* sspart = (float*)(ws + WS_SSP);
    PHASE_LOOP(5) { FRESH_IDS(); for (int m = gw; m < M; m += NGW) norm_row_mod(args.out + (size_t)m * DM, norm_g + 1024, mod + (size_t)(4 + (m >> 12)) * 3072, H1 + (size_t)m * DM, lane);
    GSYNC(); }
    PHASE_LOOP(6) {
        pg8::Gemm g{H1, W1t, M, 4096, 1024}; pg8::StaticOrder S; S.init(M, 4096, G, bx);
        EpiQKV1 E{Q1, K1, V1};
        pg8::gemm_phase<EpiQKV1, pg8::StaticOrder, true, true>(lds, g, S, E);
    GSYNC(); }
    PHASE_LOOP(7) {
        FRESH_IDS();
        const int fr = lane & 15, fq = lane >> 4;
        LAS unsigned char* qdL = lds; LAS unsigned char* kiL = lds + 33792;
        LAS float* glow = (LAS float*)(lds + 67584); LAS float* red = (LAS float*)(lds + 71680); LAS float* pref = (LAS float*)(lds + 104448);
        LAS float* wgL = (LAS float*)(lds + 112640);
        bf16x8 bfr[4];
#pragma unroll
        for (int ks = 0; ks < 4; ++ks) bfr[ks] = *(const bf16x8*)(WgT + fr * 1024 + 128 * wid + 32 * ks + 8 * fq);
        bf16x8 afr[4][4]; v2u qw[8], kw[8];
#define P7_LOAD(it_) do { const int b_ = (it_) >> 8, n_ = ((it_) >> 2) & 63, h_ = (it_) & 3; const size_t r0_ = (size_t)b_ * SEQ + (size_t)n_ * 64; \
            _Pragma("unroll") for (int ks = 0; ks < 4; ++ks) _Pragma("unroll") for (int ti = 0; ti < 4; ++ti) afr[ks][ti] = *(const bf16x8*)(H1 + (r0_ + 16 * ti + fr) * 1024 + 128 * wid + 32 * ks + 8 * fq); \
            _Pragma("unroll") for (int rr = 0; rr < 8; ++rr) { const size_t ro_ = (r0_ + 8 * wid + rr) * 1024 + h_ * 256 + 4 * lane; qw[rr] = *(const v2u*)(Q1 + ro_); kw[rr] = *(const v2u*)(K1 + ro_); } } while (0)
        int hprev = -1;
        if (vcu < 1024) P7_LOAD(vcu);
        for (int item = vcu; item < 1024; item += G) {
            const int b = item >> 8, n = (item >> 2) & 63, h = item & 3, bhn = (b * 4 + h) * 64 + n;
            const size_t r0 = (size_t)b * SEQ + (size_t)n * 64;
            const int col = h * 256 + 4 * lane;
            if (h != hprev) {
                LBAR();
#pragma unroll
                for (int q = 0; q < 2; ++q) { const int idx = tid + 512 * q, r = idx >> 6, c4 = idx & 63; *(LAS f32x4*)(wgL + r * 256 + 4 * c4) = *(const f32x4*)(gla_w_gate_up + r * 1024 + h * 256 + 4 * c4); }
                hprev = h;
            }
            {
                pg8::f32x4 gacc[4];
#pragma unroll
                for (int ti = 0; ti < 4; ++ti) gacc[ti] = (pg8::f32x4){0.f, 0.f, 0.f, 0.f};
#pragma unroll
                for (int ks = 0; ks < 4; ++ks)
#pragma unroll
                    for (int ti = 0; ti < 4; ++ti) gacc[ti] = mfma16(afr[ks][ti], bfr[ks], gacc[ti]);
#pragma unroll
                for (int ti = 0; ti < 4; ++ti)
#pragma unroll
                    for (int e = 0; e < 4; ++e) red[wid * 1024 + (16 * ti + 4 * fq + e) * 16 + fr] = gacc[ti][e];
            }
            LBAR();
#pragma unroll
            for (int q = 0; q < 2; ++q) { const int idx = tid + 512 * q; float s = 0.f;
#pragma unroll
                for (int w = 0; w < 8; ++w) s += red[w * 1024 + idx];
                glow[idx] = s; }
            LBAR();
            f32x4 bc[8];
            {
                const f32x4 bg = *(const f32x4*)(gla_b_gate + col);
#pragma unroll
                for (int rr = 0; rr < 8; ++rr) bc[rr] = bg;
#pragma unroll
                for (int r = 0; r < 16; ++r) { const f32x4 w = *(const LAS f32x4*)(wgL + r * 256 + 4 * lane);
#pragma unroll
                    for (int rr = 0; rr < 8; ++rr) { const float gl = glow[(8 * wid + rr) * 16 + r]; bc[rr] += w * gl; } }
                f32x4 run = (f32x4){0.f, 0.f, 0.f, 0.f};
#pragma unroll
                for (int rr = 0; rr < 8; ++rr) {
#pragma unroll
                    for (int i = 0; i < 4; ++i) { const float gg = bc[rr][i]; const float ls = fminf(gg, 0.f) - __logf(1.0f + __expf(-fabsf(gg))); run[i] += ls * (1.0f / 16.0f); }
                    bc[rr] = run;
                }
                *(LAS f32x4*)(pref + wid * 256 + 4 * lane) = run;
            }
            LBAR();
            f32x4 off = (f32x4){0.f, 0.f, 0.f, 0.f}, tot = (f32x4){0.f, 0.f, 0.f, 0.f};
#pragma unroll
            for (int w = 0; w < 8; ++w) { const f32x4 p = *(const LAS f32x4*)(pref + w * 256 + 4 * lane); tot += p; if (w < wid) off += p; }
            unsigned kew[4][4];
#pragma unroll
            for (int rr = 0; rr < 8; ++rr) {
                const size_t ro = (r0 + 8 * wid + rr) * 1024 + col;
                const float qv[4] = {bflo(qw[rr].x), bfhi(qw[rr].x), bflo(qw[rr].y), bfhi(qw[rr].y)}, kv[4] = {bflo(kw[rr].x), bfhi(kw[rr].x), bflo(kw[rr].y), bfhi(kw[rr].y)};
                float qd[4], ki[4], ke[4];
#pragma unroll
                for (int i = 0; i < 4; ++i) { const float bb = bc[rr][i] + off[i]; qd[i] = qv[i] * __expf(bb) * 0.0625f; ki[i] = kv[i] * __expf(-bb); ke[i] = kv[i] * __expf(tot[i] - bb); }
                v2u qo; qo.x = pk2(qd[0], qd[1]); qo.y = pk2(qd[2], qd[3]);
                v2u ko; ko.x = pk2(ki[0], ki[1]); ko.y = pk2(ki[2], ki[3]);
                if (!DRY(7)) *(v2u*)(Q1 + ro) = qo;
                *(LAS v2u*)(qdL + (8 * wid + rr) * 528 + 8 * lane) = qo;
                *(LAS v2u*)(kiL + (8 * wid + rr) * 528 + 8 * lane) = ko;
#pragma unroll
                for (int i = 0; i < 4; ++i) { const unsigned hb = f2bf(ke[i]); if (rr & 1) kew[i][rr >> 1] |= hb << 16; else kew[i][rr >> 1] = hb; }
            }
#pragma unroll
            for (int i = 0; i < 4; ++i) { v4u w; w.x = kew[i][0]; w.y = kew[i][1]; w.z = kew[i][2]; w.w = kew[i][3];
                if (!DRY(7)) *(v4u*)(keT + ((size_t)bhn * 256 + 4 * lane + i) * 64 + 8 * wid) = w; }
            if (wid == 0 && !DRY(7)) { f32x4 dv;
#pragma unroll
                for (int i = 0; i < 4; ++i) dv[i] = __expf(tot[i]);
                *(f32x4*)(decb + (size_t)bhn * 256 + 4 * lane) = dv; }
            if (item + G < 1024) P7_LOAD(item + G);
            LBAR();
            {
                const int ti = wid >> 1;
#pragma unroll
                for (int tjj = 0; tjj < 2; ++tjj) {
                    const int tj = (wid & 1) * 2 + tjj;
                    pg8::f32x4 acc0 = (pg8::f32x4){0.f, 0.f, 0.f, 0.f}, acc1 = acc0;
                    if (tj <= ti) {
#pragma unroll
                        for (int ks = 0; ks < 8; ks += 2) {
                            const bf16x8 kf = *(const LAS bf16x8*)(kiL + (16 * tj + fr) * 528 + (32 * ks + 8 * fq) * 2);
                            const bf16x8 qf = *(const LAS bf16x8*)(qdL + (16 * ti + fr) * 528 + (32 * ks + 8 * fq) * 2);
                            const bf16x8 kf1 = *(const LAS bf16x8*)(kiL + (16 * tj + fr) * 528 + (32 * ks + 32 + 8 * fq) * 2);
                            const bf16x8 qf1 = *(const LAS bf16x8*)(qdL + (16 * ti + fr) * 528 + (32 * ks + 32 + 8 * fq) * 2);
                            acc0 = mfma16(kf, qf, acc0); acc1 = mfma16(kf1, qf1, acc1);
                        }
                    }
                    const int i = 16 * ti + fr, j0 = 16 * tj + 4 * fq;
                    float o[4];
#pragma unroll
                    for (int e = 0; e < 4; ++e) o[e] = (j0 + e <= i) ? acc0[e] + acc1[e] : 0.f;
                    v2u w; w.x = pk2(o[0], o[1]); w.y = pk2(o[2], o[3]);
                    if (!DRY(7)) *(v2u*)(attnb + ((size_t)bhn * 64 + i) * 64 + j0) = w;
                }
            }
            LBAR();
        }
#undef P7_LOAD
    GSYNC(); }
    PHASE_LOOP(8) {
        FRESH_IDS();
        const int fr = lane & 15, fq = lane >> 4;
        LAS unsigned char* qdL = lds; LAS unsigned char* keL = lds + 33792; LAS unsigned char* vTL = lds + 70656; LAS unsigned char* atL = lds + 75264;
        LAS float* decL = (LAS float*)(lds + 84480); LAS unsigned char* sTL = lds + 85504;
        for (int item = vcu; item < 256; item += G) {
            const int bhh = item >> 4, vs = item & 15, b = bhh >> 2, h = bhh & 3;
            pg8::f32x4 S[2][2];
#pragma unroll
            for (int i = 0; i < 2; ++i)
#pragma unroll
                for (int j = 0; j < 2; ++j) S[i][j] = (pg8::f32x4){0.f, 0.f, 0.f, 0.f};
            LBAR();
            for (int i = tid; i < 16896 / 4; i += NTHREADS) ((LAS unsigned*)sTL)[i] = 0u;
            v4u rqA[4], rkA[4], raA; v2u rvA; f32x4 rdA;
            v4u rqB[4], rkB[4], raB; v2u rvB; f32x4 rdB;
#define P8_LOAD(X, nn) do { const size_t r0_ = (size_t)b * SEQ + (size_t)(nn) * 64; const size_t blk_ = (size_t)(bhh * 64 + (nn)); \
                _Pragma("unroll") for (int q = 0; q < 4; ++q) { const int p = tid + 512 * q; rq##X[q] = *(const v4u*)(Q1 + (r0_ + (p >> 5)) * 1024 + h * 256 + 8 * (p & 31)); rk##X[q] = *(const v4u*)(keT + blk_ * 16384 + (size_t)p * 8); } \
                rv##X = *(const v2u*)(V1 + (r0_ + (tid >> 3)) * 2048 + h * 512 + vs * 32 + 4 * (tid & 7)); \
                ra##X = *(const v4u*)(attnb + blk_ * 4096 + (size_t)tid * 8); \
                rd##X = *(const f32x4*)(decb + blk_ * 256 + 4 * (tid & 63)); } while (0)
#define P8_STAGE(X) do { \
                _Pragma("unroll") for (int q = 0; q < 4; ++q) { const int p = tid + 512 * q; *(LAS v4u*)(qdL + (p >> 5) * 528 + (p & 31) * 16) = rq##X[q]; *(LAS v4u*)(keL + (p >> 3) * 144 + (p & 7) * 16) = rk##X[q]; } \
                { const int j = tid >> 3, c4 = 4 * (tid & 7); \
                  *(LAS unsigned short*)(vTL + (c4 + 0) * 144 + j * 2) = (unsigned short)(rv##X.x & 0xffffu); *(LAS unsigned short*)(vTL + (c4 + 1) * 144 + j * 2) = (unsigned short)(rv##X.x >> 16); \
                  *(LAS unsigned short*)(vTL + (c4 + 2) * 144 + j * 2) = (unsigned short)(rv##X.y & 0xffffu); *(LAS unsigned short*)(vTL + (c4 + 3) * 144 + j * 2) = (unsigned short)(rv##X.y >> 16); } \
                *(LAS v4u*)(atL + (tid >> 3) * 144 + (tid & 7) * 16) = ra##X; \
                *(LAS f32x4*)(decL + 4 * (tid & 63)) = rd##X; } while (0)
            const int ib = wid >> 1, vb = wid & 1;
#define P8_STEP(n, XL, XS) do { \
                P8_LOAD(XL, ((n) + 2 < 64 ? (n) + 2 : 63)); \
                const size_t r0 = (size_t)b * SEQ + (size_t)(n) * 64; \
                pg8::f32x4 oa0 = (pg8::f32x4){0.f, 0.f, 0.f, 0.f}, oa1 = oa0; \
                _Pragma("unroll") for (int ks = 0; ks < 8; ks += 2) { \
                    const bf16x8 sf0 = *(const LAS bf16x8*)(sTL + (16 * vb + fr) * 528 + (32 * ks + 8 * fq) * 2); \
                    const bf16x8 qf0 = *(const LAS bf16x8*)(qdL + (16 * ib + fr) * 528 + (32 * ks + 8 * fq) * 2); \
                    const bf16x8 sf1 = *(const LAS bf16x8*)(sTL + (16 * vb + fr) * 528 + (32 * ks + 32 + 8 * fq) * 2); \
                    const bf16x8 qf1 = *(const LAS bf16x8*)(qdL + (16 * ib + fr) * 528 + (32 * ks + 32 + 8 * fq) * 2); \
                    oa0 = mfma16(sf0, qf0, oa0); oa1 = mfma16(sf1, qf1, oa1); } \
                { const bf16x8 vf0 = *(const LAS bf16x8*)(vTL + (16 * vb + fr) * 144 + (8 * fq) * 2); const bf16x8 af0 = *(const LAS bf16x8*)(atL + (16 * ib + fr) * 144 + (8 * fq) * 2); \
                  const bf16x8 vf1 = *(const LAS bf16x8*)(vTL + (16 * vb + fr) * 144 + (32 + 8 * fq) * 2); const bf16x8 af1 = *(const LAS bf16x8*)(atL + (16 * ib + fr) * 144 + (32 + 8 * fq) * 2); \
                  oa0 = mfma16(vf0, af0, oa0); oa1 = mfma16(vf1, af1, oa1); } \
                { const pg8::f32x4 oacc = oa0 + oa1; v2u w; w.x = pk2(oacc[0], oacc[1]); w.y = pk2(oacc[2], oacc[3]); \
                  if (!DRY(8)) *(v2u*)(V1 + (r0 + 16 * ib + fr) * 2048 + h * 512 + vs * 32 + 16 * vb + 4 * fq) = w; \
                  float sq = (oacc[0] * oacc[0] + oacc[1] * oacc[1]) + (oacc[2] * oacc[2] + oacc[3] * oacc[3]); sq += __shfl_xor(sq, 16); sq += __shfl_xor(sq, 32); \
                  if (!DRY(8)) sspart[((r0 + 16 * ib + fr) * 4 + h) * 32 + vs * 2 + vb] = sq; } \
                _Pragma("unroll") for (int dbi = 0; dbi < 2; ++dbi) { \
                    const int db = 2 * wid + dbi; \
                    const f32x4 dc = *(const LAS f32x4*)(decL + 16 * db + 4 * fq); \
                    _Pragma("unroll") for (int v2 = 0; v2 < 2; ++v2) _Pragma("unroll") for (int e = 0; e < 4; ++e) S[dbi][v2][e] *= dc[e]; \
                    _Pragma("unroll") for (int ks = 0; ks < 2; ++ks) { \
                        const bf16x8 kf = *(const LAS bf16x8*)(keL + (16 * db + fr) * 144 + (32 * ks + 8 * fq) * 2); \
                        _Pragma("unroll") for (int v2 = 0; v2 < 2; ++v2) { \
                            const bf16x8 vf = *(const LAS bf16x8*)(vTL + (16 * v2 + fr) * 144 + (32 * ks + 8 * fq) * 2); \
                            S[dbi][v2] = mfma16(kf, vf, S[dbi][v2]); } } } \
                LBAR(); \
                _Pragma("unroll") for (int dbi = 0; dbi < 2; ++dbi) _Pragma("unroll") for (int v2 = 0; v2 < 2; ++v2) { v2u w; w.x = pk2(S[dbi][v2][0], S[dbi][v2][1]); w.y = pk2(S[dbi][v2][2], S[dbi][v2][3]); \
                        *(LAS v2u*)(sTL + (16 * v2 + fr) * 528 + (16 * (2 * wid + dbi) + 4 * fq) * 2) = w; } \
                P8_STAGE(XS); \
                LBAR(); } while (0)
            P8_LOAD(A, 0);
            P8_STAGE(A);
            P8_LOAD(B, 1);
            LBAR();
            for (int n = 0; n < 64; n += 2) {
                P8_STEP(n, A, B);
                P8_STEP(n + 1, B, A);
            }
#undef P8_LOAD
#undef P8_STAGE
#undef P8_STEP
        }
    GSYNC(); }
    PHASE_LOOP(10) {
        pg8::Gemm g{H1, W1t + (size_t)4096 * 1024, M, 2048, 1024}; pg8::StaticOrder S; S.init(M, 2048, G, bx);
        EpiGate<true> E{V1, sspart, gla_norm_w, DRY(10)};
        pg8::gemm_phase<EpiGate<true>, pg8::StaticOrder, true, true>(lds, g, S, E);
    GSYNC(); }
    PHASE_LOOP(11) {
        pg8::Gemm g{V1, Wo1t, M, 1024, 2048}; pg8::StaticOrder S; S.init(M, 1024, G, bx);
        EpiRes E{args.out, args.out, mod + 4 * 3072 + 2048, DRY(11)};
        pg8::gemm_phase<EpiRes, pg8::StaticOrder, true, true>(lds, g, S, E);
    GSYNC(); }
#endif
    if (DUP_PHASE == 20) { for (int i = 0; i < 10; ++i) GSYNC(); }
    { FRESH_IDS();
    for (int m = gw; m < M; m += NGW) {
        f32x4* xr = (f32x4*)(args.out + (size_t)m * DM) + lane;
        f32x4 v[4]; float s = 0.f;
#pragma unroll
        for (int j = 0; j < 4; ++j) { v[j] = xr[64 * j]; s += (v[j][0] * v[j][0] + v[j][1] * v[j][1]) + (v[j][2] * v[j][2] + v[j][3] * v[j][3]); }
        const float rstd = 1.0f / sqrtf(wave_sum(s) * (1.0f / DM) + EPS);
#pragma unroll
        for (int j = 0; j < 4; ++j) { const f32x4 gg = ((const f32x4*)final_g)[lane + 64 * j]; f32x4 o;
#pragma unroll
            for (int i = 0; i < 4; ++i) o[i] = v[j][i] * rstd * gg[i];
            xr[64 * j] = o; }
    } }
}

extern "C" void kernel_launch(void* const* d_in, const int* in_sizes, int n_in, void* d_out, int out_size, void* d_ws, size_t ws_size, hipStream_t stream) {
    static int grid = 0;
    if (grid == 0) {
        if (n_in != 19 || out_size != M * DM || ws_size < WS_END) { fprintf(stderr, "kernel_launch: unexpected shapes (n_in %d out %d ws %zu)\n", n_in, out_size, ws_size); grid = -1; return; }
        int dev = 0, cus = 0, per_cu = 0;
        hipGetDevice(&dev); hipDeviceGetAttribute(&cus, hipDeviceAttributeMultiprocessorCount, dev);
        hipFuncSetAttribute((const void*)fwd_mega, hipFuncAttributeMaxDynamicSharedMemorySize, LDS_BYTES);
        hipOccupancyMaxActiveBlocksPerMultiprocessor(&per_cu, (const void*)fwd_mega, NTHREADS, LDS_BYTES);
        (void)hipGetLastError();
        if (per_cu < 1) per_cu = 1;
        grid = cus;
        if (grid > 256) grid = 256;
    }
    if (grid < 0) return;
    if (hipMemsetAsync((char*)d_ws + WS_BAR, 0, WS_BAR_BYTES, stream) != hipSuccess) { fprintf(stderr, "memset failed\n"); return; }
    Args a{};
    for (int i = 0; i < 19; ++i) a.in[i] = d_in[i];
    a.out = (float*)d_out; a.ws = (unsigned char*)d_ws;
    void* kargs[] = {&a};
    hipError_t e = hipLaunchCooperativeKernel((const void*)fwd_mega, dim3(grid), dim3(NTHREADS), kargs, LDS_BYTES, stream);
    if (e != hipSuccess) fprintf(stderr, "cooperative launch failed: %s (grid %d)\n", hipGetErrorString(e), grid);
}
```

```cpp
#include <hip/hip_runtime.h>
#include <hip/hip_cooperative_groups.h>
#include <cstdio>
#include <cstdint>
namespace pg8 {
#define PG8_LAS __attribute__((address_space(3)))
typedef unsigned short bf16_t;
typedef short bf16x8 __attribute__((ext_vector_type(8)));
typedef float f32x4 __attribute__((ext_vector_type(4)));
typedef unsigned u32x4 __attribute__((ext_vector_type(4)));
constexpr int BM = 256, BK = 64, HALF = 128, HTB = HALF * BK * 2  , STAGE_BYTES = 8 * HTB, NXCD = 8, WGM = 8;

__host__ __device__ __forceinline__ int lds_byte(int r, int c) { const int st = (r >> 4) * 2 + (c >> 5), rr = r & 15, cc = c & 31, ob = rr * 64 + cc * 2; return st * 1024 + (ob ^ (((ob >> 9) & 1) << 5)); }
__host__ __device__ __forceinline__ void stage_rc(int b, int& R, int& C) { const int st = b / 1024, sb = b % 1024, swz = sb ^ (((sb >> 9) & 1) << 5); R = (st >> 1) * 16 + swz / 64; C = (st & 1) * 32 + (swz % 64) / 2; }
__host__ __device__ __forceinline__ int perm32(int rho) { const int n = rho >> 4, i = rho & 15; return 8 * (i >> 2) + 4 * n + (i & 3); }

struct Unit { int pm, pn; };
struct Gemm { const bf16_t* A; const bf16_t* Bt; int M, N, K; };

struct StaticOrder {
    int nM, nN, nwg, G, c;
    __host__ __device__ void init(int M, int N, int G_, int c_) { nM = M / BM; nN = N / BM; nwg = nM * nN; G = G_; c = c_; }
    __host__ __device__ bool next(int i, Unit& u) const {
        const long L = (long)i * G + c; if (L >= nwg) return false;
        int wgid = (int)L; { const int q = nwg / NXCD, r = nwg % NXCD, xcd = wgid % NXCD, off = wgid / NXCD; wgid = (xcd < r ? xcd * (q + 1) : r * (q + 1) + (xcd - r) * q) + off; }
        const int nig = WGM * nN, gid = wgid / nig, fm = gid * WGM, gsz = (nM - fm) < WGM ? (nM - fm) : WGM;
        u.pm = fm + ((wgid % nig) % gsz); u.pn = (wgid % nig) / gsz; return true;
    }
    __device__ __forceinline__ void a_ready(const Unit&) const {}
    __device__ __forceinline__ void done(const Unit&) const {}
};

__device__ __forceinline__ unsigned cvt_pk_bf16(float lo, float hi) { unsigned r; asm volatile("v_cvt_pk_bf16_f32 %0, %1, %2" : "=v"(r) : "v"(lo), "v"(hi)); return r; }
typedef float f32x2 __attribute__((ext_vector_type(2)));
__device__ __forceinline__ f32x2 gelu_pk(f32x2 v) {
    const f32x2 av = __builtin_elementwise_abs(v), d = av * 0.2316418882f + 1.0f;
    f32x2 t; t.x = __builtin_amdgcn_rcpf(d.x); t.y = __builtin_amdgcn_rcpf(d.y);
    f32x2 q = t * 0.5307027145f + (-0.7265760135f); q = q * t + 0.7107068705f; q = q * t + (-0.142248368f); q = q * t + 0.127414796f; q = q * t;
    const f32x2 s = (v * v) * (-0.72134752044f);
    f32x2 e; e.x = __builtin_amdgcn_exp2f(s.x); e.y = __builtin_amdgcn_exp2f(s.y);
    const f32x2 m = v * (q * e), r = v - m;
    f32x2 o; o.x = v.x < 0.f ? m.x : r.x; o.y = v.y < 0.f ? m.y : r.y; return o;
}

template <int ACT  > struct EpiBf16 {
    static constexpr bool PERM = true, AFTER_DRAIN = false; static_assert(ACT == 0 || ACT == 1, "EpiBf16: ACT is 0 (none) or 1 (gelu_pk)");
    bf16_t* O; int ldc; const float* bias; int split_cols; size_t split_stride; float scale0;
    __device__ __forceinline__ void operator()(const f32x4 (&acc)[2][2][4][2], const Unit& u, int wr, int wc, int fr, int fq) const {
        const int row0 = u.pm * BM + wr * 64 + fr; int colt = u.pn * BM; bf16_t* base = O;
        float sc = 1.f; if (split_cols) { const int t = colt / split_cols; base += (size_t)t * split_stride; colt -= t * split_cols; if (t == 0) sc = scale0; }
        const int col0 = colt + wc * 32 + 8 * fq, bcol0 = u.pn * BM + wc * 32 + 8 * fq;
        f32x4 bv[2][2];
#pragma unroll
        for (int bj = 0; bj < 2; ++bj)
#pragma unroll
            for (int n = 0; n < 2; ++n) bv[bj][n] = bias ? *(const f32x4*)(bias + bcol0 + bj * HALF + 4 * n) : (f32x4){0.f, 0.f, 0.f, 0.f};
#pragma unroll
        for (int ai = 0; ai < 2; ++ai)
#pragma unroll
            for (int m = 0; m < 4; ++m) { bf16_t* rowp = base + (size_t)(row0 + ai * HALF + m * 16) * ldc + col0;
#pragma unroll
                for (int bj = 0; bj < 2; ++bj) { f32x4 v0 = acc[ai][bj][m][0] + bv[bj][0], v1 = acc[ai][bj][m][1] + bv[bj][1];
                    if (ACT == 1) { f32x2 a = gelu_pk((f32x2){v0[0], v0[1]}), b = gelu_pk((f32x2){v0[2], v0[3]}), c = gelu_pk((f32x2){v1[0], v1[1]}), d = gelu_pk((f32x2){v1[2], v1[3]});
                        v0 = (f32x4){a.x, a.y, b.x, b.y}; v1 = (f32x4){c.x, c.y, d.x, d.y}; }
                    v0 = v0 * sc; v1 = v1 * sc; u32x4 w; w.x = cvt_pk_bf16(v0[0], v0[1]); w.y = cvt_pk_bf16(v0[2], v0[3]); w.z = cvt_pk_bf16(v1[0], v1[1]); w.w = cvt_pk_bf16(v1[2], v1[3]);
                    *(u32x4*)(rowp + bj * HALF) = w; } }
    }
};


template <class Epi, class Sched, bool ALIGN_EPI = false, bool SP2 = false>
__device__ __forceinline__ void gemm_phase(PG8_LAS unsigned char* lds, const Gemm g, const Sched& S, const Epi& E) {
    int tid_ = threadIdx.x; asm volatile("" : "+v"(tid_)); const int tid = tid_, wid = __builtin_amdgcn_readfirstlane(tid >> 6), lane = tid & 63, wr = wid >> 2, wc = wid & 3, fr = lane & 15, fq = lane >> 4;
    const int K = g.K, nt = K / BK;
    unsigned voffA[2], voffB[2];
#pragma unroll
    for (int i = 0; i < 2; ++i) { int R, C; stage_rc(tid * 16 + i * 8192, R, C); const int Rb = Epi::PERM ? ((R & ~31) + perm32(R & 31)) : R;
        voffA[i] = (unsigned)(R * K + C) * 2u; voffB[i] = (unsigned)(Rb * K + C) * 2u; }
    const size_t kstep = (size_t)(BK * 2);
    const size_t hstep = (size_t)HALF * K * 2;
    const size_t tstep = 2 * hstep;
    const unsigned ldsw = (unsigned)wid * 1024u;
    const int aoff = lds_byte(wr * 64 + fr, fq * 8), boff = lds_byte(wc * 32 + fr, fq * 8);
#define PG8_SA(b, h) (((b) * 2 + (h)) * HTB)
#define PG8_SB(b, h) ((4 + (b) * 2 + (h)) * HTB)
#define PG8_STAGE(bufoff, gbase, voff) do { _Pragma("unroll") for (int _i = 0; _i < 2; ++_i) \
        __builtin_amdgcn_global_load_lds((const unsigned*)((const char*)(gbase) + (voff)[_i]), (PG8_LAS unsigned*)(lds + (bufoff) + ldsw + _i * 8192), 16, 0, 0); } while (0)
#define PG8_LDA(dst, b, h) do { _Pragma("unroll") for (int m = 0; m < 4; ++m) _Pragma("unroll") for (int k = 0; k < 2; ++k) dst[m][k] = *(const PG8_LAS bf16x8*)(lds + PG8_SA(b, h) + aoff + m * 2048 + k * 1024); } while (0)
#define PG8_LDB(dst, b, h) do { _Pragma("unroll") for (int n = 0; n < 2; ++n) _Pragma("unroll") for (int k = 0; k < 2; ++k) dst[n][k] = *(const PG8_LAS bf16x8*)(lds + PG8_SB(b, h) + boff + n * 2048 + k * 1024); } while (0)
#define PG8_MMA(ai, bj, At, Bt) do { __builtin_amdgcn_s_setprio(1); _Pragma("unroll") for (int m = 0; m < 4; ++m) _Pragma("unroll") for (int n = 0; n < 2; ++n) _Pragma("unroll") for (int k = 0; k < 2; ++k) \
        acc[ai][bj][m][n] = __builtin_amdgcn_mfma_f32_16x16x32_bf16(Bt[n][k], At[m][k], acc[ai][bj][m][n], 0, 0, 0); __builtin_amdgcn_s_setprio(0); } while (0)
#define PG8_WAIT_V(n) asm volatile("s_waitcnt vmcnt(" #n ")" ::: "memory")
#define PG8_WAIT_L(n) asm volatile("s_waitcnt lgkmcnt(" #n ")" ::: "memory")
#define PG8_BAR __builtin_amdgcn_s_barrier()
#define PG8_SCHED __builtin_amdgcn_sched_barrier(0)
    Unit cur, nxt; int ui = 0;
    if (!S.next(0, cur)) return;
    f32x4 acc[2][2][4][2];
#pragma unroll
    for (int a = 0; a < 2; ++a)
#pragma unroll
        for (int b = 0; b < 2; ++b)
#pragma unroll
            for (int m = 0; m < 4; ++m)
#pragma unroll
                for (int n = 0; n < 2; ++n) acc[a][b][m][n] = (f32x4){0.f, 0.f, 0.f, 0.f};
    bf16x8 At[4][2], B0[2][2], B1[2][2];
    const char* cA = (const char*)g.A + (size_t)cur.pm * tstep; const char* cB = (const char*)g.Bt + (size_t)cur.pn * tstep;
    S.a_ready(cur);
    if constexpr (SP2) {
        PG8_STAGE(PG8_SB(0, 0), cB, voffB); PG8_STAGE(PG8_SB(0, 1), cB + hstep, voffB); PG8_STAGE(PG8_SA(0, 0), cA, voffA); PG8_STAGE(PG8_SA(0, 1), cA + hstep, voffA);
        if (wr == 1) PG8_BAR;
        PG8_WAIT_V(2); PG8_BAR;
        PG8_STAGE(PG8_SB(1, 0), cB + kstep, voffB); PG8_STAGE(PG8_SA(1, 0), cA + kstep, voffA); PG8_STAGE(PG8_SB(1, 1), cB + hstep + kstep, voffB);
        PG8_WAIT_V(6); PG8_BAR;
    } else {
        PG8_STAGE(PG8_SB(0, 0), cB, voffB); PG8_STAGE(PG8_SA(0, 0), cA, voffA); PG8_STAGE(PG8_SB(0, 1), cB + hstep, voffB); PG8_STAGE(PG8_SA(0, 1), cA + hstep, voffA);
        if (wr == 1) PG8_BAR;
        PG8_WAIT_V(4); PG8_BAR;
        PG8_STAGE(PG8_SB(1, 0), cB + kstep, voffB); PG8_STAGE(PG8_SA(1, 0), cA + kstep, voffA); PG8_STAGE(PG8_SB(1, 1), cB + hstep + kstep, voffB);
        PG8_WAIT_V(6); PG8_BAR;
    }
    for (;;) {
        const bool has_next = S.next(ui + 1, nxt);
        const char* nA = has_next ? (const char*)g.A + (size_t)nxt.pm * tstep : cA; const char* nB = has_next ? (const char*)g.Bt + (size_t)nxt.pn * tstep : cB;
        for (int t = 0; t < nt; t += 2) {
            const bool last = (t == nt - 2);
            const char* a1 = cA + (size_t)(t + 1) * kstep;
            const char* a2 = last ? nA : cA + (size_t)(t + 2) * kstep; const char* b2 = last ? nB : cB + (size_t)(t + 2) * kstep;
            const char* a3 = a2 + kstep; const char* b3 = b2 + kstep;
            if (last && has_next) S.a_ready(nxt);
            if constexpr (SP2) {
            PG8_LDB(B0, 0, 0); PG8_LDB(B1, 0, 1); PG8_SCHED; PG8_LDA(At, 0, 0); PG8_STAGE(PG8_SA(1, 1), a1 + hstep, voffA);
            PG8_WAIT_V(8); PG8_WAIT_L(0); PG8_BAR; PG8_MMA(0, 0, At, B0); PG8_MMA(0, 1, At, B1); PG8_BAR; PG8_SCHED;
            PG8_LDA(At, 0, 1); PG8_STAGE(PG8_SB(0, 0), b2, voffB); PG8_STAGE(PG8_SB(0, 1), b2 + hstep, voffB); PG8_STAGE(PG8_SA(0, 0), a2, voffA);
            PG8_WAIT_V(8); PG8_WAIT_L(0); PG8_BAR; PG8_MMA(1, 0, At, B0); PG8_MMA(1, 1, At, B1); PG8_BAR; PG8_SCHED;
            PG8_LDB(B0, 1, 0); PG8_LDB(B1, 1, 1); PG8_SCHED; PG8_LDA(At, 1, 0); PG8_STAGE(PG8_SA(0, 1), a2 + hstep, voffA);
            PG8_WAIT_V(8); PG8_WAIT_L(0); PG8_BAR; PG8_MMA(0, 0, At, B0); PG8_MMA(0, 1, At, B1); PG8_BAR; PG8_SCHED;
            PG8_LDA(At, 1, 1); PG8_STAGE(PG8_SB(1, 0), b3, voffB); PG8_STAGE(PG8_SB(1, 1), b3 + hstep, voffB); PG8_STAGE(PG8_SA(1, 0), a3, voffA);
            PG8_WAIT_V(8); PG8_WAIT_L(0); PG8_BAR; PG8_MMA(1, 0, At, B0); PG8_MMA(1, 1, At, B1); PG8_BAR; PG8_SCHED;
            } else {
            PG8_LDB(B0, 0, 0); PG8_SCHED; PG8_LDA(At, 0, 0); PG8_STAGE(PG8_SA(1, 1), a1 + hstep, voffA);
            PG8_WAIT_L(8); PG8_BAR; PG8_WAIT_L(0); PG8_MMA(0, 0, At, B0); PG8_BAR; PG8_SCHED;
            PG8_LDB(B1, 0, 1); PG8_STAGE(PG8_SB(0, 0), b2, voffB);
            PG8_BAR; PG8_WAIT_L(0); PG8_MMA(0, 1, At, B1); PG8_BAR;
            PG8_LDA(At, 0, 1); PG8_STAGE(PG8_SA(0, 0), a2, voffA);
            PG8_BAR; PG8_WAIT_L(0); PG8_MMA(1, 0, At, B0); PG8_BAR; PG8_SCHED;
            PG8_STAGE(PG8_SB(0, 1), b2 + hstep, voffB);
            PG8_WAIT_V(6); PG8_BAR; PG8_MMA(1, 1, At, B1); PG8_BAR;
            PG8_LDB(B0, 1, 0); PG8_SCHED; PG8_LDA(At, 1, 0); PG8_STAGE(PG8_SA(0, 1), a2 + hstep, voffA);
            PG8_WAIT_L(8); PG8_BAR; PG8_WAIT_L(0); PG8_MMA(0, 0, At, B0); PG8_BAR; PG8_SCHED;
            PG8_LDB(B1, 1, 1); PG8_STAGE(PG8_SB(1, 0), b3, voffB);
            PG8_BAR; PG8_WAIT_L(0); PG8_MMA(0, 1, At, B1); PG8_BAR;
            PG8_LDA(At, 1, 1); PG8_STAGE(PG8_SA(1, 0), a3, voffA);
            PG8_BAR; PG8_WAIT_L(0); PG8_MMA(1, 0, At, B0); PG8_BAR; PG8_SCHED;
            PG8_STAGE(PG8_SB(1, 1), b3 + hstep, voffB);
            PG8_WAIT_V(6); PG8_BAR; PG8_MMA(1, 1, At, B1); PG8_BAR;
            }
        }
        if constexpr (ALIGN_EPI) { if (wr == 0) PG8_BAR; }
        if constexpr (!Epi::AFTER_DRAIN) { E(acc, cur, wr, wc, fr, fq); S.done(cur); }
        if (!has_next) break;
#pragma unroll
        for (int a = 0; a < 2; ++a)
#pragma unroll
            for (int b = 0; b < 2; ++b)
#pragma unroll
                for (int m = 0; m < 4; ++m)
#pragma unroll
                    for (int n = 0; n < 2; ++n) acc[a][b][m][n] = (f32x4){0.f, 0.f, 0.f, 0.f};
        cur = nxt; cA = nA; cB = nB; ++ui;
        if constexpr (ALIGN_EPI) { if (wr == 1) PG8_BAR; }
    }
    PG8_WAIT_V(0);
    if constexpr (!ALIGN_EPI) { if (wr == 0) PG8_BAR; }
    PG8_BAR;
    if constexpr (Epi::AFTER_DRAIN) { E.fused(acc, cur, wr, wc, fr, fq, lds, wid, lane); S.done(cur); }
#undef PG8_SA
#undef PG8_SB
#undef PG8_STAGE
#undef PG8_LDA
#undef PG8_LDB
#undef PG8_MMA
#undef PG8_WAIT_V
#undef PG8_WAIT_L
#undef PG8_BAR
#undef PG8_SCHED
}
}
#include <hip/hip_bf16.h>
#include <cmath>
namespace attn_body {
using bf16=__hip_bfloat16;
using bf16x8=__attribute__((ext_vector_type(8)))short;
using s16x4=__attribute__((ext_vector_type(4)))short;
using f32x16=__attribute__((ext_vector_type(16)))float;
using u32x4=__attribute__((ext_vector_type(4)))unsigned;
constexpr int D=64,QP=2048,KP=2048,VP=2048,OP=64;
constexpr int NW=8,QBLK=32,QB=QBLK*NW,KVBLK=64;
constexpr int ATTN_UNIT_ROWS=QB;
__device__ __forceinline__ int crow(int r,int hi){return (r&3)+8*(r>>2)+4*hi;}
#define SBAR() __builtin_amdgcn_sched_barrier(0)
__device__ __forceinline__ void cmask(f32x16&p0,f32x16&p1,int jb,int qrel,int hi){
  const float NEG=-INFINITY; int kb=64*jb+4*hi;
  #pragma unroll
  for(int r=0;r<16;++r){int kv=kb+(r&3)+8*(r>>2); if(kv>qrel)p0[r]=NEG; if(kv+32>qrel)p1[r]=NEG;}
}

constexpr int NSLOT=3, SLOTB=8192;
constexpr int LDS_K=0, LDS_V=NSLOT*SLOTB, LDS_WS=2*NSLOT*SLOTB, LDS_OST=LDS_WS+NW*64*4, LDS_BYTES=LDS_OST+NW*4096;
constexpr float C2=0.125f*1.4426950408889634f;
__device__ __forceinline__ void glds16(const void*gsrc,unsigned lds_dst){unsigned keep;
  asm volatile("s_mov_b32 %0, m0\n\ts_mov_b32 m0, %2\n\ts_nop 0\n\tglobal_load_lds_dwordx4 %1, off\n\ts_mov_b32 m0, %0":"=&s"(keep):"v"(gsrc),"s"(lds_dst):"memory");}
__device__ __forceinline__ float max3f(float a,float b,float c){float r;asm("v_max3_f32 %0, %1, %2, %3":"=v"(r):"v"(a),"v"(b),"v"(c));return r;}
__device__ __forceinline__ float max2f(float a,float b){float r;asm("v_max_f32_e32 %0, %1, %2":"=v"(r):"v"(a),"v"(b));return r;}
__device__ __forceinline__ float fadd_s(float a,float b){float r;asm("v_add_f32_e32 %0, %1, %2":"=v"(r):"v"(a),"v"(b));return r;}
__device__ __forceinline__ float fsub_s(float a,float b){float r;asm("v_sub_f32_e32 %0, %1, %2":"=v"(r):"v"(a),"v"(b));return r;}
typedef float f32x2_t __attribute__((ext_vector_type(2))); typedef __bf16 bf16x2_t __attribute__((ext_vector_type(2)));
__device__ __forceinline__ unsigned cvtpk_s(float lo,float hi){f32x2_t v={lo,hi};bf16x2_t b=__builtin_convertvector(v,bf16x2_t);return __builtin_bit_cast(unsigned,b);}
#define WAIT_BAR(N) asm volatile("s_waitcnt vmcnt(" #N ") lgkmcnt(0)\n\ts_barrier":::"memory")

__device__ __forceinline__ void qkt(f32x16&p0,f32x16&p1,const char*Kslot,const bf16x8*qr,const f32x16&negm,int r32,int hi){
  const char*kb=Kslot+hi*1024+r32*16;
  #pragma unroll
  for(int d0=0;d0<4;++d0){
    const bf16x8 b0=*reinterpret_cast<const bf16x8*>(kb+d0*2048);
    const bf16x8 b1=*reinterpret_cast<const bf16x8*>(kb+d0*2048+512);
    if(d0==0){p0=__builtin_amdgcn_mfma_f32_32x32x16_bf16(b0,qr[0],negm,0,0,0);p1=__builtin_amdgcn_mfma_f32_32x32x16_bf16(b1,qr[0],negm,0,0,0);}
    else{p0=__builtin_amdgcn_mfma_f32_32x32x16_bf16(b0,qr[d0],p0,0,0,0);p1=__builtin_amdgcn_mfma_f32_32x32x16_bf16(b1,qr[d0],p1,0,0,0);}}
}
typedef __attribute__((address_space(3))) const char* lds_cptr;
typedef short v4i16_t __attribute__((ext_vector_type(4)));
__device__ __forceinline__ void kload8(bf16x8*kf,lds_cptr kp){
  kf[0]=*(const __attribute__((address_space(3))) bf16x8*)(kp);      kf[1]=*(const __attribute__((address_space(3))) bf16x8*)(kp+512);
  kf[2]=*(const __attribute__((address_space(3))) bf16x8*)(kp+2048); kf[3]=*(const __attribute__((address_space(3))) bf16x8*)(kp+2560);
  kf[4]=*(const __attribute__((address_space(3))) bf16x8*)(kp+4096); kf[5]=*(const __attribute__((address_space(3))) bf16x8*)(kp+4608);
  kf[6]=*(const __attribute__((address_space(3))) bf16x8*)(kp+6144); kf[7]=*(const __attribute__((address_space(3))) bf16x8*)(kp+6656);
}
__device__ __forceinline__ void kload2(bf16x8*kf,lds_cptr kp,int j){ kf[2*j]=*(const __attribute__((address_space(3))) bf16x8*)(kp+j*2048); kf[2*j+1]=*(const __attribute__((address_space(3))) bf16x8*)(kp+j*2048+512); }
__device__ __forceinline__ s16x4 vtr(lds_cptr p){ return __builtin_bit_cast(s16x4,__builtin_amdgcn_ds_read_tr16_b64_v4i16((__attribute__((address_space(3))) v4i16_t*)p)); }
__device__ __forceinline__ float rowmax(const f32x16&p0,const f32x16&p1){
  float a=max3f(p0[0],p0[1],p1[0]),b=max3f(p0[2],p0[3],p1[1]);a=max3f(a,p1[2],p1[3]);
  #pragma unroll
  for(int r=4;r<16;r+=4){a=max3f(a,p0[r],p0[r+1]);b=max3f(b,p0[r+2],p0[r+3]);a=max3f(a,p1[r],p1[r+1]);b=max3f(b,p1[r+2],p1[r+3]);}
  const float m=max2f(a,b);
  auto rr=__builtin_amdgcn_permlane32_swap(__float_as_uint(m),__float_as_uint(m),false,false);
  return max2f(__uint_as_float(rr[0]),__uint_as_float(rr[1]));
}
__device__ __forceinline__ void pv(f32x16*o,int vb,bf16x8 pa0,bf16x8 pa1,bf16x8 pa2,bf16x8 pa3){
  #pragma unroll
  for(int d0=0;d0<2;++d0){s16x4 lo[4],hi[4];
    #pragma unroll
    for(int ks=0;ks<4;++ks){
      asm volatile("ds_read_b64_tr_b16 %0,%1 offset:%c2":"=&v"(lo[ks]):"v"(vb),"i"(d0*4096+ks*1024):"memory");
      asm volatile("ds_read_b64_tr_b16 %0,%1 offset:%c2":"=&v"(hi[ks]):"v"(vb),"i"(d0*4096+ks*1024+512):"memory");}
    asm volatile("s_waitcnt lgkmcnt(0)":::"memory");SBAR();
    #define PK(k) (bf16x8){lo[k][0],lo[k][1],lo[k][2],lo[k][3],hi[k][0],hi[k][1],hi[k][2],hi[k][3]}
    o[d0]=__builtin_amdgcn_mfma_f32_32x32x16_bf16(pa0,PK(0),o[d0],0,0,0);
    o[d0]=__builtin_amdgcn_mfma_f32_32x32x16_bf16(pa1,PK(1),o[d0],0,0,0);
    o[d0]=__builtin_amdgcn_mfma_f32_32x32x16_bf16(pa2,PK(2),o[d0],0,0,0);
    o[d0]=__builtin_amdgcn_mfma_f32_32x32x16_bf16(pa3,PK(3),o[d0],0,0,0);
    #undef PK
  }
}

#ifndef ATTN_STORE16
#define ATTN_STORE16(p,v) (*(u32x4*)(p)=(v))
#endif
template<int THRL> __device__ __forceinline__ void attn_unit(int qb,const bf16*Qu,const bf16*__restrict__ Kh,const bf16*__restrict__ Vh,bf16*Ou,char*shm){
  int tid_=threadIdx.x; asm volatile("":"+v"(tid_)); const int tid=tid_,lane=tid&63,r32=lane&31,hi=lane>>5; const int wid=__builtin_amdgcn_readfirstlane(tid>>6);
  const int q0=qb*QB;
  const bf16*Qw=Qu+(long)(wid*QBLK)*QP;
  const unsigned lds0=(unsigned)(uintptr_t)shm;
  float*wsf=(float*)(shm+LDS_WS)+wid*64;
  const bf16*ksrc=Kh+(long)lane*KP+wid*8;
  const bf16*vsrc=Vh+(long)(16*(wid&3)+(lane>>2))*VP+(wid>>2)*32+(lane&3)*8;
  const unsigned kdst=lds0+LDS_K+wid*1024, vdst=lds0+LDS_V+wid*1024;
  #define DMA_K(t,slot) glds16(ksrc+(long)(t)*KVBLK*KP,(unsigned)__builtin_amdgcn_readfirstlane(kdst+(slot)))
  #define DMA_V(t,slot) glds16(vsrc+(long)(t)*KVBLK*VP,(unsigned)__builtin_amdgcn_readfirstlane(vdst+(slot)))
  const int vb0=(int)(lds0+LDS_V)+((lane>>4)&1)*32+(lane&3)*8+(4*hi+((lane&15)>>2))*64;
  const char*Kbase=shm+LDS_K; bf16x8 kf[8];
  const lds_cptr shm3=(lds_cptr)shm; const lds_cptr kp0=shm3+LDS_K+hi*1024+r32*16; const lds_cptr vp0=shm3+LDS_V+((lane>>4)&1)*32+(lane&3)*8+(4*hi+((lane&15)>>2))*64;
  const int NT=(q0+QB)/KVBLK;
  DMA_K(0,0);DMA_V(0,0);DMA_K(1,SLOTB);
  bf16x8 qr[4];
  #pragma unroll
  for(int d0=0;d0<4;++d0)qr[d0]=*reinterpret_cast<const bf16x8*>(&Qw[(long)r32*QP+d0*16+hi*8]);
  float mhat=0.f,l_reg=0.f;f32x16 o[2];o[0]=f32x16{};o[1]=f32x16{};f32x16 negm=f32x16{};asm volatile("":"+v"(negm));
  const int qrel=wid*QBLK+r32;
  #define CMASK(P0,P1,t) do{int jb_=(t)-(NT-4); if(jb_>=0)cmask(P0,P1,jb_,qrel,hi);}while(0)
  bool resc=false;
  #define START(P0,P1) do{ const float rm=rowmax(P0,P1); resc=false; \
    { const float dl=rm; mhat=fadd_s(mhat,dl); \
      _Pragma("unroll") for(int r=0;r<16;++r){P0[r]=fsub_s(P0[r],dl);P1[r]=fsub_s(P1[r],dl);} \
      _Pragma("unroll") for(int r=0;r<16;++r)negm[r]=-mhat; asm volatile("":"+v"(negm)); } \
    _Pragma("unroll") for(int r=0;r<16;++r)P0[r]=__builtin_amdgcn_exp2f(P0[r]); }while(0)
  #define RESC() do{ if(resc){ asm volatile("s_waitcnt lgkmcnt(0)":::"memory"); \
      _Pragma("unroll") for(int d_=0;d_<2;++d_) _Pragma("unroll") for(int r=0;r<16;++r)o[d_][r]*=wsf[crow(r,hi)]; } }while(0)
  f32x16 pA0,pA1,pB0,pB1;
  int sl_prev=0,sl_cur=0,sl_next=SLOTB;
  #define ROT() do{sl_prev=sl_cur;sl_cur=sl_next;sl_next=(sl_next==(NSLOT-1)*SLOTB)?0:sl_next+SLOTB;}while(0)
  DMA_K(2,2*SLOTB);
  WAIT_BAR(3);
  qkt(pA0,pA1,Kbase,qr,negm,r32,hi);asm volatile("s_nop 15\n\ts_nop 7":"+v"(pA0),"+v"(pA1));CMASK(pA0,pA1,0);
  START(pA0,pA1);
  _Pragma("unroll") for(int r=0;r<16;++r)pA1[r]=__builtin_amdgcn_exp2f(pA1[r]);
  WAIT_BAR(0);
  DMA_K(3,0);DMA_V(1,SLOTB);
  ROT();
  kload8(kf,kp0+sl_cur);
  WAIT_BAR(2);
  s16x4 vlo[8],vhi[8]; u32x4 pw0,pw1,pw2,pw3;
  #define PKW(P,B) cvtpk_s(P[B],P[B+1])
  #define PAF(k) __builtin_bit_cast(bf16x8,pw##k)
  #define VFR(i) (bf16x8){vlo[i][0],vlo[i][1],vlo[i][2],vlo[i][3],vhi[i][0],vhi[i][1],vhi[i][2],vhi[i][3]}
  #define PIN(x) asm volatile("":"+v"(x))
  #define MX3(a,b,c) __builtin_fmaxf(__builtin_fmaxf((a),(b)),(c))
  #define GAPA(MF,A0,A1,A2,A3,W0,W1,PW) do{ MF; sacc+=A0; sacc+=A1; sacc+=A2; sacc+=A3; PIN(sacc); W0; W1; PIN(PW); SBAR(); }while(0)
  #define EX(v) __builtin_amdgcn_exp2f(v)
  #define GAPB(MF,X,B) do{ MF; X[B]=EX(X[B]); X[B+1]=EX(X[B+1]); X[B+2]=EX(X[B+2]); X[B+3]=EX(X[B+3]); PIN(X); SBAR(); }while(0)
  #define VRD(i) do{ vlo[i]=vtr(vp_+(((i)>>2)*4096+((i)&3)*1024)); vhi[i]=vtr(vp_+(((i)>>2)*4096+((i)&3)*1024+512)); }while(0)
  #define KRD(G,j) do{ if(G){ kload2(kf,kp0+sl_next,j); SBAR(); } }while(0)
  #define STEP(C0,C1,P0,P1,t,GK,GV,GL) do{ SBAR(); \
    const lds_cptr vp_=vp0+sl_prev; \
    VRD(0); SBAR(); float sacc=(P0[0]+P0[1]); \
    GAPA(C0=__builtin_amdgcn_mfma_f32_32x32x16_bf16(kf[0],qr[0],negm,0,0,0), P0[2],P0[3],P0[4],P0[5],     pw0[0]=PKW(P0,0), pw0[1]=PKW(P0,2), pw0); \
    VRD(4); SBAR(); GAPA(C1=__builtin_amdgcn_mfma_f32_32x32x16_bf16(kf[1],qr[0],negm,0,0,0), P0[6],P0[7],P0[8],P0[9],     pw0[2]=PKW(P0,4), pw0[3]=PKW(P0,6), pw0); \
    VRD(1); SBAR(); GAPA(C0=__builtin_amdgcn_mfma_f32_32x32x16_bf16(kf[2],qr[1],C0,0,0,0),   P0[10],P0[11],P0[12],P0[13], pw1[0]=PKW(P0,8), pw1[1]=PKW(P0,10), pw1); \
    VRD(5); SBAR(); GAPA(C1=__builtin_amdgcn_mfma_f32_32x32x16_bf16(kf[3],qr[1],C1,0,0,0),   P0[14],P0[15],P1[0],P1[1],   pw1[2]=PKW(P0,12),pw1[3]=PKW(P0,14), pw1); \
    VRD(2); SBAR(); GAPA(C0=__builtin_amdgcn_mfma_f32_32x32x16_bf16(kf[4],qr[2],C0,0,0,0),   P1[2],P1[3],P1[4],P1[5],     pw2[0]=PKW(P1,0), pw2[1]=PKW(P1,2), pw2); \
    VRD(6); SBAR(); GAPA(C1=__builtin_amdgcn_mfma_f32_32x32x16_bf16(kf[5],qr[2],C1,0,0,0),   P1[6],P1[7],P1[8],P1[9],     pw2[2]=PKW(P1,4), pw2[3]=PKW(P1,6), pw2); \
    VRD(3); SBAR(); GAPA(C0=__builtin_amdgcn_mfma_f32_32x32x16_bf16(kf[6],qr[3],C0,0,0,0),   P1[10],P1[11],P1[12],P1[13], pw3[0]=PKW(P1,8), pw3[1]=PKW(P1,10), pw3); \
    VRD(7); SBAR(); GAPA(C1=__builtin_amdgcn_mfma_f32_32x32x16_bf16(kf[7],qr[3],C1,0,0,0),   P1[14],P1[15],0.f,0.f,       pw3[2]=PKW(P1,12),pw3[3]=PKW(P1,14), pw3); \
    l_reg+=sacc; \
    if(GK){DMA_K((t)+3,sl_cur);} if(GV){DMA_V((t)+1,sl_next);} \
    CMASK(C0,C1,t); \
    { float a=MX3(C0[0],C0[1],C1[0]),b=MX3(C0[2],C0[3],C1[1]); a=MX3(a,C1[2],C1[3]); \
      _Pragma("unroll") for(int r=4;r<16;r+=4){a=MX3(a,C0[r],C0[r+1]);b=MX3(b,C0[r+2],C0[r+3]);a=MX3(a,C1[r],C1[r+1]);b=MX3(b,C1[r+2],C1[r+3]);} \
      float rm=__builtin_fmaxf(a,b); { auto rr=__builtin_amdgcn_permlane32_swap(__float_as_uint(rm),__float_as_uint(rm),false,false); rm=__builtin_fmaxf(__uint_as_float(rr[0]),__uint_as_float(rr[1])); } \
      resc=false; \
      if(__builtin_expect(__any(rm>(float)THRL),0)){ const float dl=__builtin_fmaxf(rm,0.f); mhat+=dl; \
        _Pragma("unroll") for(int r=0;r<16;++r){C0[r]-=dl;C1[r]-=dl;} \
        _Pragma("unroll") for(int r=0;r<16;++r)negm[r]=-mhat; asm volatile("":"+v"(negm)); \
        const float f=__builtin_amdgcn_exp2f(-dl); l_reg*=f; if(hi==0)wsf[r32]=f; resc=true; } } \
    SBAR(); \
    GAPB(o[0]=__builtin_amdgcn_mfma_f32_32x32x16_bf16(PAF(0),VFR(0),o[0],0,0,0), C0,0); \
    GAPB(o[1]=__builtin_amdgcn_mfma_f32_32x32x16_bf16(PAF(0),VFR(4),o[1],0,0,0), C0,4); \
    KRD(GL,0); GAPB(o[0]=__builtin_amdgcn_mfma_f32_32x32x16_bf16(PAF(1),VFR(1),o[0],0,0,0), C0,8); \
    KRD(GL,1); GAPB(o[1]=__builtin_amdgcn_mfma_f32_32x32x16_bf16(PAF(1),VFR(5),o[1],0,0,0), C0,12); \
    KRD(GL,2); GAPB(o[0]=__builtin_amdgcn_mfma_f32_32x32x16_bf16(PAF(2),VFR(2),o[0],0,0,0), C1,0); \
    KRD(GL,3); GAPB(o[1]=__builtin_amdgcn_mfma_f32_32x32x16_bf16(PAF(2),VFR(6),o[1],0,0,0), C1,4); \
    GAPB(o[0]=__builtin_amdgcn_mfma_f32_32x32x16_bf16(PAF(3),VFR(3),o[0],0,0,0), C1,8); \
    GAPB(o[1]=__builtin_amdgcn_mfma_f32_32x32x16_bf16(PAF(3),VFR(7),o[1],0,0,0), C1,12); \
    }while(0)
  int t=1;
  #undef CMASK
  #define CMASK(P0,P1,t) do{}while(0)
  for(;t+5<NT;t+=2){
    STEP(pB0,pB1,pA0,pA1,t,true,true,true);     WAIT_BAR(2); RESC(); ROT();
    STEP(pA0,pA1,pB0,pB1,t+1,true,true,true);   WAIT_BAR(2); RESC(); ROT();
  }
  #undef CMASK
  #define CMASK(P0,P1,t) do{int jb_=(t)-(NT-4); if(jb_>=0)cmask(P0,P1,jb_,qrel,hi);}while(0)
  #define ENDW(tt) do{ if((tt)+3<NT){WAIT_BAR(2);} else if((tt)+2<NT){WAIT_BAR(1);} else {WAIT_BAR(0);} }while(0)
  for(;t+1<NT;t+=2){
    STEP(pB0,pB1,pA0,pA1,t,(t+3<NT),(t+1<NT),(t+1<NT));       ENDW(t);   RESC(); ROT();
    STEP(pA0,pA1,pB0,pB1,t+1,(t+4<NT),(t+2<NT),(t+2<NT));     ENDW(t+1); RESC(); ROT();
  }
  STEP(pB0,pB1,pA0,pA1,NT-1,false,false,false); RESC();
  { float sacc=pB0[0]+pB0[1]; _Pragma("unroll") for(int r=2;r<16;++r)sacc+=pB0[r]; _Pragma("unroll") for(int r=0;r<16;++r)sacc+=pB1[r]; l_reg+=sacc;
    pw0=(u32x4){PKW(pB0,0),PKW(pB0,2),PKW(pB0,4),PKW(pB0,6)};pw1=(u32x4){PKW(pB0,8),PKW(pB0,10),PKW(pB0,12),PKW(pB0,14)};pw2=(u32x4){PKW(pB1,0),PKW(pB1,2),PKW(pB1,4),PKW(pB1,6)};pw3=(u32x4){PKW(pB1,8),PKW(pB1,10),PKW(pB1,12),PKW(pB1,14)};
    SBAR(); pv(o,vb0+sl_cur,PAF(0),PAF(1),PAF(2),PAF(3)); }
  #undef PKW
  #undef PAF
  #undef VFR
  #undef PIN
  #undef MX3
  #undef GAPA
  #undef GAPB
  #undef EX
  #undef VRD
  #undef KRD
  #undef STEP
  #undef ENDW
  {auto rr=__builtin_amdgcn_permlane32_swap(__float_as_uint(l_reg),__float_as_uint(l_reg),false,false);l_reg=__uint_as_float(rr[0])+__uint_as_float(rr[1]);}
  if(hi==0)wsf[32+r32]=l_reg;asm volatile("s_waitcnt lgkmcnt(0)":::"memory");
  float rli[16];
  #pragma unroll
  for(int r=0;r<16;++r)rli[r]=__builtin_amdgcn_rcpf(wsf[32+crow(r,hi)]);
  bf16*Ow=Ou+(long)(wid*QBLK)*OP;
  { bf16*stg=(bf16*)(shm+LDS_OST)+wid*2048;
    #pragma unroll
    for(int r=0;r<16;++r){const int orow=crow(r,hi);
      #pragma unroll
      for(int d0=0;d0<2;++d0)stg[orow*64+d0*32+r32]=__float2bfloat16(o[d0][r]*rli[r]);}
    asm volatile("s_waitcnt lgkmcnt(0)":::"memory");
    #pragma unroll
    for(int i=0;i<4;++i){const int row=i*8+(lane>>3),ch=lane&7; const u32x4 v=*(const u32x4*)(stg+row*64+ch*8); ATTN_STORE16(Ow+(long)row*OP+ch*8,v);} }
  asm volatile("s_waitcnt lgkmcnt(0)\n\ts_barrier":::"memory");
  #undef DMA_K
  #undef DMA_V
  #undef CMASK
  #undef START
  #undef RESC
  #undef ROT
}
constexpr int ATTN_LDS_BYTES=LDS_BYTES;
#undef SBAR
#undef WAIT_BAR
}
namespace da {
typedef unsigned short bf16;
typedef short bf16x8 __attribute__((ext_vector_type(8)));
typedef short s16x4 __attribute__((ext_vector_type(4)));
typedef float f32x16 __attribute__((ext_vector_type(16)));
typedef float f32x4 __attribute__((ext_vector_type(4)));
typedef unsigned u32x4 __attribute__((ext_vector_type(4)));
constexpr int NW = 8, QBLK = 32, KVBLK = 64, QB = NW * QBLK;
constexpr int QP = 2048, KP = 2048, VP = 2048, OP = 128;
constexpr int SHM_V = KVBLK * 128 * 2, SHM_K = KVBLK * 64 * 2;
constexpr int LDS_BYTES = 2 * SHM_V + 2 * SHM_K + NW * 64 * 4;
constexpr float THRL = 11.5f;
#define DA_KSWZ(row, colB) ((row) * 128 + ((colB) ^ (((row) & 7) << 4)))
#define DA_SBAR() __builtin_amdgcn_sched_barrier(0)
__device__ __forceinline__ int v_st(int k, int c) { const int kk = (k & ~0xC) | ((k & 4) << 1) | ((k & 8) >> 1); return ((kk >> 3) * 4 + (c >> 5)) * 512 + ((kk & 7) * 32 + (c & 31)) * 2; }
__device__ __forceinline__ int v_rd_base(int lane) { return ((lane & 3) << 3) | (((lane >> 2) & 3) << 6) | (((lane >> 4) & 1) << 5) | (((lane >> 5) & 1) << 8); }
constexpr int v_rd_off(int d0, int ks, int half) { return d0 * 512 + ks * 4096 + half * 2048; }
__device__ __forceinline__ int crow(int r, int hi) { return (r & 3) + 8 * (r >> 2) + 4 * hi; }
__device__ __forceinline__ unsigned cvtpk(float lo, float hi) { unsigned r; asm volatile("v_cvt_pk_bf16_f32 %0, %1, %2" : "=v"(r) : "v"(lo), "v"(hi)); return r; }
__device__ __forceinline__ void mask_tile(f32x16& p0, f32x16& p1, int dq) {
    const float NEG = -__builtin_inff();
#pragma unroll
    for (int r = 0; r < 16; ++r) { const int c = (r & 3) + 8 * (r >> 2); if (dq - c < 0) p0[r] = NEG; if (dq - c - 32 < 0) p1[r] = NEG; }
}
__device__ __forceinline__ void partialSM(f32x16& p0, f32x16& p1, float& m_reg, float& mn, float& alpha) {
    float pmax = p0[0];
#pragma unroll
    for (int r = 1; r < 16; ++r) pmax = fmaxf(pmax, p0[r]);
#pragma unroll
    for (int r = 0; r < 16; ++r) pmax = fmaxf(pmax, p1[r]);
    { auto rr = __builtin_amdgcn_permlane32_swap(__float_as_uint(pmax), __float_as_uint(pmax), false, false); pmax = fmaxf(__uint_as_float(rr[0]), __uint_as_float(rr[1])); }
    if (__builtin_expect(__all((pmax - m_reg) <= THRL), 1)) { mn = m_reg; alpha = 1.f; }
    else { mn = fmaxf(m_reg, pmax); alpha = __builtin_amdgcn_exp2f(m_reg - mn); m_reg = mn; }
#pragma unroll
    for (int r = 0; r < 16; ++r) p0[r] = p0[r] - mn;
#pragma unroll
    for (int r = 0; r < 16; ++r) p1[r] = p1[r] - mn;
#pragma unroll
    for (int r = 0; r < 16; ++r) p0[r] = __builtin_amdgcn_exp2f(p0[r]);
}
__device__ __forceinline__ void finishSM(f32x16& p0, f32x16& p1, float alpha, float& l_reg, bf16x8& pa0, bf16x8& pa1, bf16x8& pa2, bf16x8& pa3) {
#pragma unroll
    for (int r = 0; r < 16; ++r) p1[r] = __builtin_amdgcn_exp2f(p1[r]);
    float ps = 0;
#pragma unroll
    for (int r = 0; r < 16; ++r) ps += p0[r];
#pragma unroll
    for (int r = 0; r < 16; ++r) ps += p1[r];
    { auto rr = __builtin_amdgcn_permlane32_swap(__float_as_uint(ps), __float_as_uint(ps), false, false); ps = __uint_as_float(rr[0]) + __uint_as_float(rr[1]); }
    l_reg = l_reg * alpha + ps;
#define DA_PK4(P, B_, OUT) do { unsigned a0 = cvtpk(P[B_+0], P[B_+1]), a1 = cvtpk(P[B_+2], P[B_+3]); unsigned b0 = cvtpk(P[B_+4], P[B_+5]), b1 = cvtpk(P[B_+6], P[B_+7]); \
        auto r0 = __builtin_amdgcn_permlane32_swap(a0, b0, false, false); auto r1 = __builtin_amdgcn_permlane32_swap(a1, b1, false, false); \
        u32x4 w = {r0[0], r1[0], r0[1], r1[1]}; OUT = *reinterpret_cast<bf16x8*>(&w); } while (0)
    DA_PK4(p0, 0, pa0); DA_PK4(p0, 8, pa1); DA_PK4(p1, 0, pa2); DA_PK4(p1, 8, pa3);
#undef DA_PK4
}
template <int KB>
__device__ __forceinline__ void qkt(f32x16& p0, f32x16& p1, const char* K_lds, int r32, int hi, const bf16x8* qr) {
    p0 = f32x16{}; p1 = f32x16{};
#pragma unroll
    for (int d0 = 0; d0 < 4; ++d0) { const char* a = K_lds + KB * SHM_K + DA_KSWZ(r32, (d0 * 16 + hi * 8) * 2);
        bf16x8 b0 = *reinterpret_cast<const bf16x8*>(a);
        bf16x8 b1 = *reinterpret_cast<const bf16x8*>(a + 32 * 128);
        p0 = __builtin_amdgcn_mfma_f32_32x32x16_bf16(b0, qr[d0], p0, 0, 0, 0);
        p1 = __builtin_amdgcn_mfma_f32_32x32x16_bf16(b1, qr[d0], p1, 0, 0, 0); }
}
template <int VB>
__device__ __forceinline__ void pv_tile(f32x16* o, int vb0, bf16x8 pa0, bf16x8 pa1, bf16x8 pa2, bf16x8 pa3) {
#define DA_TRRD(dst, off) asm volatile("ds_read_b64_tr_b16 %0, %1 offset:%2" : "=&v"(dst) : "v"(vb0), "i"(off) : "memory")
#define DA_PV_D0(d0) do { s16x4 l0, l1, l2, l3, h0, h1, h2, h3; constexpr int b_ = VB * SHM_V + v_rd_off(d0, 0, 0); \
        DA_TRRD(l0, b_); DA_TRRD(h0, b_ + 2048); DA_TRRD(l1, b_ + 4096); DA_TRRD(h1, b_ + 6144); DA_TRRD(l2, b_ + 8192); DA_TRRD(h2, b_ + 10240); DA_TRRD(l3, b_ + 12288); DA_TRRD(h3, b_ + 14336); \
        asm volatile("s_waitcnt lgkmcnt(0)" ::: "memory"); DA_SBAR(); \
        o[d0] = __builtin_amdgcn_mfma_f32_32x32x16_bf16(pa0, (bf16x8){l0[0], l0[1], l0[2], l0[3], h0[0], h0[1], h0[2], h0[3]}, o[d0], 0, 0, 0); \
        o[d0] = __builtin_amdgcn_mfma_f32_32x32x16_bf16(pa1, (bf16x8){l1[0], l1[1], l1[2], l1[3], h1[0], h1[1], h1[2], h1[3]}, o[d0], 0, 0, 0); \
        o[d0] = __builtin_amdgcn_mfma_f32_32x32x16_bf16(pa2, (bf16x8){l2[0], l2[1], l2[2], l2[3], h2[0], h2[1], h2[2], h2[3]}, o[d0], 0, 0, 0); \
        o[d0] = __builtin_amdgcn_mfma_f32_32x32x16_bf16(pa3, (bf16x8){l3[0], l3[1], l3[2], l3[3], h3[0], h3[1], h3[2], h3[3]}, o[d0], 0, 0, 0); } while (0)
    DA_PV_D0(0); DA_PV_D0(1); DA_PV_D0(2); DA_PV_D0(3);
#undef DA_PV_D0
#undef DA_TRRD
}
struct BlockRef { const bf16* Q; const bf16* K; const bf16* V; bf16* O; int P0; };
struct Seam { bf16x8 qr[4]; bf16x8 st_v0, st_v1, st_k0; };
#define DA_VMW() asm volatile("s_waitcnt vmcnt(0)" ::: "memory")
#define DA_VMWN(n) asm volatile("s_waitcnt vmcnt(%0)" :: "i"(n) : "memory")
#define DA_SLOAD(Kp, Vp, k0) do { S.st_v0 = *(const bf16x8*)((Vp) + (size_t)((k0) + sr) * VP + sc); S.st_v1 = *(const bf16x8*)((Vp) + (size_t)((k0) + 32 + sr) * VP + sc); \
                                  S.st_k0 = *(const bf16x8*)((Kp) + (size_t)((k0) + kr) * KP + kc); } while (0)
#define DA_SWRITE_K(bf) do { *(bf16x8*)(K_lds + (bf) * SHM_K + kws) = S.st_k0; } while (0)
#define DA_SWRITE_V(bf) do { *(bf16x8*)(V_lds + (bf) * SHM_V + vst0) = S.st_v0; *(bf16x8*)(V_lds + (bf) * SHM_V + vst1) = S.st_v1; } while (0)
__device__ __forceinline__ void prime(const BlockRef& cur, char* lds, Seam& S) {
    int tid_ = threadIdx.x; asm volatile("" : "+v"(tid_)); const int tid = tid_, wid = __builtin_amdgcn_readfirstlane(tid >> 6), lane = tid & 63, r32 = lane & 31, hi = lane >> 5;
    const int sr = tid >> 4, sc = (tid & 15) * 8, kr = tid >> 3, kc = (tid & 7) * 8, kws = DA_KSWZ(kr, kc * 2); char* K_lds = lds + 2 * SHM_V;
#pragma unroll
    for (int d0 = 0; d0 < 4; ++d0) S.qr[d0] = *(const bf16x8*)(cur.Q + (size_t)(wid * QBLK + r32) * QP + d0 * 16 + hi * 8);
    DA_SLOAD(cur.K, cur.V, 0); DA_VMW(); DA_SWRITE_K(0);
    __syncthreads();
}
__device__ __forceinline__ void block(const BlockRef& cur, const BlockRef& nxt, char* lds, Seam& S) {
    int tid_ = threadIdx.x; asm volatile("" : "+v"(tid_)); const int tid = tid_, wid = __builtin_amdgcn_readfirstlane(tid >> 6), lane = tid & 63, r32 = lane & 31, hi = lane >> 5;
    const int NT = (cur.P0 + QB) / KVBLK;
    const int qlo = cur.P0 + wid * QBLK, qm = qlo + r32 - 4 * hi;
    char* V_lds = lds; char* K_lds = lds + 2 * SHM_V;
    float* wsf = (float*)(lds + 2 * SHM_V + 2 * SHM_K) + wid * 64; float* li_l = wsf, * al_l = wsf + 32;
    float m_reg = -1e30f, l_reg = 0; f32x16 o[4] = {};
    const int sr = tid >> 4, sc = (tid & 15) * 8, vst0 = v_st(sr, sc), vst1 = v_st(32 + sr, sc), kr = tid >> 3, kc = (tid & 7) * 8, kws = DA_KSWZ(kr, kc * 2);
    const int vb0 = (int)(uintptr_t)V_lds + v_rd_base(lane);
    const bf16* Kh = cur.K; const bf16* Vh = cur.V;
#define DA_RESC(a) do { if (__any((a) < 1.f)) { if (hi == 0) al_l[r32] = (a); asm volatile("s_waitcnt lgkmcnt(0)" ::: "memory"); \
                     _Pragma("unroll") for (int d_ = 0; d_ < 4; ++d_) _Pragma("unroll") for (int r = 0; r < 16; ++r) o[d_][r] *= al_l[crow(r, hi)]; } } while (0)
#define DA_KBASE(t) ((t) * KVBLK)
#define DA_MASKT(P0_, P1_, t) do { const int kb_ = DA_KBASE(t); if (kb_ + KVBLK - 1 > qlo) mask_tile(P0_, P1_, qm - kb_); } while (0)
    f32x16 pA0, pA1, pB0, pB1; float mnA, mnB, alA, alB; bf16x8 pa0, pa1, pa2, pa3;
    DA_SWRITE_V(0); DA_SBAR();
    DA_SLOAD(Kh, Vh, DA_KBASE(1));
    DA_SBAR(); qkt<0>(pA0, pA1, K_lds, r32, hi, S.qr);
    DA_MASKT(pA0, pA1, 0); partialSM(pA0, pA1, m_reg, mnA, alA);
    DA_VMW(); DA_SWRITE_V(1); DA_SWRITE_K(1);
    __syncthreads();
#define DA_HALF_STEP(PX0, PX1, mnX, alX, PY0, PY1, alY, t, KB, VB, SB) do { \
        DA_SBAR(); qkt<KB>(PX0, PX1, K_lds, r32, hi, S.qr); \
        finishSM(PY0, PY1, alY, l_reg, pa0, pa1, pa2, pa3); DA_SBAR(); \
        if ((t) + 1 < NT) { DA_SLOAD(Kh, Vh, DA_KBASE((t) + 1)); DA_SBAR(); } \
        pv_tile<VB>(o, vb0, pa0, pa1, pa2, pa3); DA_MASKT(PX0, PX1, (t)); partialSM(PX0, PX1, m_reg, mnX, alX); \
        __syncthreads(); \
        if ((t) + 1 < NT) { DA_VMW(); DA_SWRITE_V(SB); DA_SWRITE_K(SB); } \
        DA_RESC(alX); __syncthreads(); } while (0)
    for (int t = 1; t + 1 < NT; t += 2) {
        DA_HALF_STEP(pB0, pB1, mnB, alB, pA0, pA1, alA, t, 1, 0, 0);
        DA_HALF_STEP(pA0, pA1, mnA, alA, pB0, pB1, alB, t + 1, 0, 1, 1);
    }
    DA_SBAR(); qkt<1>(pB0, pB1, K_lds, r32, hi, S.qr); DA_SBAR();
    DA_SLOAD(nxt.K, nxt.V, 0); DA_SBAR();
#pragma unroll
    for (int d0 = 0; d0 < 4; ++d0) S.qr[d0] = *(const bf16x8*)(nxt.Q + (size_t)(wid * QBLK + r32) * QP + d0 * 16 + hi * 8);
    DA_SBAR();
    finishSM(pA0, pA1, alA, l_reg, pa0, pa1, pa2, pa3); DA_SBAR();
    pv_tile<0>(o, vb0, pa0, pa1, pa2, pa3);
    DA_MASKT(pB0, pB1, NT - 1); partialSM(pB0, pB1, m_reg, mnB, alB); __syncthreads(); DA_RESC(alB);
    finishSM(pB0, pB1, alB, l_reg, pa0, pa1, pa2, pa3); DA_SBAR(); pv_tile<1>(o, vb0, pa0, pa1, pa2, pa3);
    DA_SBAR(); DA_VMWN(4); DA_SWRITE_K(0); DA_SBAR();
    if (hi == 0) li_l[r32] = l_reg; asm volatile("s_waitcnt lgkmcnt(0)" ::: "memory");
    float rli[16];
#pragma unroll
    for (int r = 0; r < 16; ++r) rli[r] = __builtin_amdgcn_rcpf(li_l[crow(r, hi)]);
    bf16* Ow = cur.O + (size_t)(wid * QBLK) * OP;
#pragma unroll
    for (int r = 0; r < 16; ++r) { const int orow = crow(r, hi);
#pragma unroll
        for (int d0 = 0; d0 < 4; ++d0) { const float v = o[d0][r] * rli[r]; const float vn = __shfl_xor(v, 1);
            if ((r32 & 1) == 0) *(unsigned*)(Ow + (size_t)orow * OP + d0 * 32 + r32) = cvtpk(v, vn); } }
    __syncthreads();
#undef DA_RESC
#undef DA_KBASE
#undef DA_MASKT
#undef DA_HALF_STEP
}
#undef DA_VMW
#undef DA_VMWN
#undef DA_SLOAD
#undef DA_SWRITE_K
#undef DA_SWRITE_V
#undef DA_KSWZ
#undef DA_SBAR
}
namespace cg = cooperative_groups;
#define LAS __attribute__((address_space(3)))
typedef unsigned short bf16;
typedef unsigned v4u __attribute__((ext_vector_type(4)));
typedef unsigned v2u __attribute__((ext_vector_type(2)));
typedef float f32x4 __attribute__((ext_vector_type(4)));
typedef float f32x2 __attribute__((ext_vector_type(2)));
typedef short bf16x8 __attribute__((ext_vector_type(8)));

constexpr int NWAVES = 8, NTHREADS = 512;
constexpr int BATCH = 4, SEQ = 4096, DM = 1024, M = BATCH * SEQ, DI = 2048;
constexpr float EPS = 1e-6f;
constexpr size_t MiB = 1u << 20;
constexpr size_t WS_MOD = 0;
constexpr size_t WS_BAR = 512 * 1024, WS_BAR_BYTES = 16384;
constexpr size_t WS_WGT = 256 * 1024;
constexpr size_t WS_W0T = 1 * MiB;
constexpr size_t WS_WO0T = 17 * MiB;
constexpr size_t WS_W1T = 21 * MiB;
constexpr size_t WS_WO1T = 33 * MiB;
constexpr size_t WS_ROPE = 37 * MiB;
constexpr size_t WS_DEC = 37 * MiB;
constexpr size_t WS_SSP = 41 * MiB;
constexpr size_t WS_ATTN = 1 * MiB;
constexpr size_t WS_Q = 64 * MiB, WS_K = 128 * MiB, WS_V = 192 * MiB;
constexpr size_t WS_Q1 = 64 * MiB, WS_K1 = 96 * MiB;
constexpr size_t WS_H1 = 128 * MiB, WS_KET = 160 * MiB;
constexpr size_t WS_V1 = 192 * MiB;
constexpr size_t WS_END = 256 * MiB;
constexpr size_t OUT_H0 = 0;
constexpr size_t OUT_OSC = 32 * MiB;
constexpr int LDS_BYTES = 147456;

#define LDS_WAIT() asm volatile("s_waitcnt lgkmcnt(0)" ::: "memory")
#define LBAR() do { asm volatile("s_waitcnt lgkmcnt(0)" ::: "memory"); __builtin_amdgcn_s_barrier(); asm volatile("" ::: "memory"); } while (0)
#define VM_WAIT() asm volatile("s_waitcnt vmcnt(0)" ::: "memory")
__device__ __forceinline__ unsigned f2bf(float f) { unsigned u = __builtin_bit_cast(unsigned, f); return (u + 0x7fffu + ((u >> 16) & 1u)) >> 16; }
typedef float f32x2_cv __attribute__((ext_vector_type(2))); typedef __bf16 bf16x2_cv __attribute__((ext_vector_type(2)));
__device__ __forceinline__ unsigned pk2(float lo, float hi) { f32x2_cv v = {lo, hi}; bf16x2_cv r = __builtin_convertvector(v, bf16x2_cv); return __builtin_bit_cast(unsigned, r); }
__device__ __forceinline__ float bflo(unsigned w) { return __builtin_bit_cast(float, w << 16); }
__device__ __forceinline__ float bfhi(unsigned w) { return __builtin_bit_cast(float, w & 0xffff0000u); }
__device__ __forceinline__ float silu_f(float z) { return z * __builtin_amdgcn_rcpf(1.0f + __builtin_amdgcn_exp2f(-1.4426950408889634f * z)); }
__device__ __forceinline__ float wave_sum(float v) {
#pragma unroll
    for (int o = 1; o < 64; o <<= 1) v += __shfl_xor(v, o);
    return v;
}

struct Args { const void* in[19]; float* out; unsigned char* ws; };

#define XB_TMO      128
#define XB_XCNT(j)  (256  + 64 * (j))
#define XB_XSUB(j)  (1280 + 64 * (j))
#define XB_XGEN(j)  (2304 + 64 * (j))
#define XB_TOP      3328
#define XB_TOPGEN   3392
#define XCD_BAR_WORDS 3456
#define XB_SPIN_CAP (1u << 18)

__device__ __forceinline__ unsigned xb_ld(unsigned* p)              { return __hip_atomic_load(p, __ATOMIC_RELAXED, __HIP_MEMORY_SCOPE_AGENT); }
__device__ __forceinline__ unsigned xb_add(unsigned* p, unsigned v) { return __hip_atomic_fetch_add(p, v, __ATOMIC_RELAXED, __HIP_MEMORY_SCOPE_AGENT); }
__device__ __forceinline__ unsigned xb_xcc_id() { return (unsigned)__builtin_amdgcn_s_getreg((3 << 11) | 20) & 0xFu; }
#define XB_SPIN(cond, bar) do { unsigned _sp = 0; while (cond) { __builtin_amdgcn_s_sleep(1); \
    if ((++_sp & 255u) == 0u) { if (xb_ld(&(bar)[XB_TMO])) break; if (_sp > XB_SPIN_CAP) { atomicAdd(&(bar)[XB_TMO], 1u); break; } } } } while (0)

struct XcdBarrier {
    unsigned* bar; unsigned x;
    volatile LAS unsigned* st;
};

__device__ __forceinline__ XcdBarrier xcd_barrier_post(unsigned* bar, volatile LAS unsigned* st) {
    XcdBarrier b; b.bar = bar; b.x = xb_xcc_id(); b.st = st;
    if (threadIdx.x == 0) (void)xb_add(&bar[XB_XCNT(b.x)], 1u);
    return b;
}
__device__ __forceinline__ void xcd_barrier_complete(unsigned* bar, unsigned x, unsigned& nloc, unsigned& nx) {
    const unsigned G = gridDim.x * gridDim.y * gridDim.z;
    unsigned sum, cnt, mine, sp = 0u;
    for (;;) {
        sum = 0u; cnt = 0u; mine = 0u;
#pragma unroll
        for (unsigned j = 0; j < 16; ++j) { const unsigned c = xb_ld(&bar[XB_XCNT(j)]); sum += c; cnt += (c > 0u) ? 1u : 0u; mine = (j == x) ? c : mine; }
        if (sum == G) break;
        __builtin_amdgcn_s_sleep(1);
        if ((++sp & 255u) == 0u) { if (xb_ld(&bar[XB_TMO])) break; if (sp > XB_SPIN_CAP) { atomicAdd(&bar[XB_TMO], 1u); break; } }
    }
    nloc = mine > 0u ? mine : 1u; nx = cnt > 0u ? cnt : 1u;
}

__device__ __forceinline__ void xcd_barrier(const XcdBarrier& b) {
    asm volatile("s_waitcnt vmcnt(0)" ::: "memory");
    __syncthreads();
    if (threadIdx.x == 0) {
        unsigned* bar = b.bar;
        __builtin_amdgcn_s_waitcnt(0);
        unsigned nloc = b.st[0], nx = b.st[1];
        if (nloc == 0u) { xcd_barrier_complete(bar, b.x, nloc, nx); b.st[0] = nloc; b.st[1] = nx; }
        const unsigned old = xb_add(&bar[XB_XSUB(b.x)], 1u);
        const unsigned gen = old / nloc;
        if (old + 1u == (gen + 1u) * nloc) {
            __builtin_amdgcn_fence(__ATOMIC_RELEASE, "agent");
            asm volatile("s_waitcnt vmcnt(0)" ::: "memory");
            const unsigned og = xb_add(&bar[XB_TOP], 1u);
            const unsigned tg = og / nx;
            if (og + 1u == (tg + 1u) * nx) xb_add(&bar[XB_TOPGEN], 1u);
            else XB_SPIN(xb_ld(&bar[XB_TOPGEN]) == tg, bar);
            __builtin_amdgcn_fence(__ATOMIC_ACQUIRE, "agent");
            xb_add(&bar[XB_XGEN(b.x)], 1u);
            asm volatile("s_waitcnt vmcnt(0)" ::: "memory");
        } else {
            XB_SPIN(xb_ld(&bar[XB_XGEN(b.x)]) == gen, bar);
            __builtin_amdgcn_fence(__ATOMIC_ACQUIRE, "agent");
            asm volatile("s_waitcnt vmcnt(0)" ::: "memory");
        }
    }
    __syncthreads();
}

struct EpiQKV0 {
    static constexpr bool PERM = true, AFTER_DRAIN = false;
    bf16* Q; bf16* K; bf16* V; const float* rope;
    __device__ __forceinline__ void operator()(const pg8::f32x4 (&acc)[2][2][4][2], const pg8::Unit& u, int wr, int wc, int fr, int fq) const {
        const int row0 = u.pm * 256 + wr * 64 + fr; const int colt = u.pn * 256; const int t = colt >> 11;
        const int cr0 = (colt & 2047) + wc * 32 + 8 * fq;
        bf16* base = Q + (size_t)t * (size_t)(32u << 20);
        if (t < 2) {
            const int g4 = 4 * (4 * (wc & 1) + fq);
            const float sc = t == 0 ? 0.125f * 1.4426950408889634f : 1.0f;
#pragma unroll
            for (int ai = 0; ai < 2; ++ai)
#pragma unroll
                for (int m = 0; m < 4; ++m) {
                    const int row = row0 + ai * 128 + m * 16;
                    const f32x4 cs0 = *(const f32x4*)(rope + ((size_t)row * 32 + g4) * 2), cs1 = *(const f32x4*)(rope + ((size_t)row * 32 + g4) * 2 + 4);
                    const float c0 = cs0[0] * sc, s0 = cs0[1] * sc, c1 = cs0[2] * sc, s1 = cs0[3] * sc, c2 = cs1[0] * sc, s2 = cs1[1] * sc, c3 = cs1[2] * sc, s3 = cs1[3] * sc;
                    bf16* rowp = base + (size_t)row * 2048 + cr0;
#pragma unroll
                    for (int bj = 0; bj < 2; ++bj) {
                        const pg8::f32x4 a = acc[ai][bj][m][0], b = acc[ai][bj][m][1];
                        v4u w;
                        w.x = pk2(a[0] * c0 - b[0] * s0, a[1] * c1 - b[1] * s1); w.y = pk2(a[2] * c2 - b[2] * s2, a[3] * c3 - b[3] * s3);
                        w.z = pk2(b[0] * c0 + a[0] * s0, b[1] * c1 + a[1] * s1); w.w = pk2(b[2] * c2 + a[2] * s2, b[3] * c3 + a[3] * s3);
                        *(v4u*)(rowp + bj * 128) = w;
                    }
                }
        } else {
#pragma unroll
            for (int ai = 0; ai < 2; ++ai)
#pragma unroll
                for (int m = 0; m < 4; ++m) {
                    bf16* rowp = base + (size_t)(row0 + ai * 128 + m * 16) * 2048 + cr0;
#pragma unroll
                    for (int bj = 0; bj < 2; ++bj) {
                        const pg8::f32x4 a = acc[ai][bj][m][0], b = acc[ai][bj][m][1];
                        v4u w; w.x = pk2(a[0], a[1]); w.y = pk2(a[2], a[3]); w.z = pk2(b[0], b[1]); w.w = pk2(b[2], b[3]);
                        *(v4u*)(rowp + bj * 128) = w;
                    }
                }
        }
    }
};
struct EpiQKV1 {
    static constexpr bool PERM = true, AFTER_DRAIN = false;
    bf16* Q; bf16* K; bf16* V;
    __device__ __forceinline__ void operator()(const pg8::f32x4 (&acc)[2][2][4][2], const pg8::Unit& u, int wr, int wc, int fr, int fq) const {
        const int row0 = u.pm * 256 + wr * 64 + fr; const int colt = u.pn * 256;
        bf16* base; int pitch, c0;
        if (colt < 2048) { base = Q + (size_t)(colt >> 10) * (size_t)(16u << 20); pitch = 1024; c0 = colt & 1023; } else { base = V; pitch = 2048; c0 = colt - 2048; }
        c0 += wc * 32 + 8 * fq;
#pragma unroll
        for (int ai = 0; ai < 2; ++ai)
#pragma unroll
            for (int m = 0; m < 4; ++m) {
                bf16* rowp = base + (size_t)(row0 + ai * 128 + m * 16) * pitch + c0;
#pragma unroll
                for (int bj = 0; bj < 2; ++bj) {
                    const pg8::f32x4 a = acc[ai][bj][m][0], b = acc[ai][bj][m][1];
                    v4u w; w.x = pk2(a[0], a[1]); w.y = pk2(a[2], a[3]); w.z = pk2(b[0], b[1]); w.w = pk2(b[2], b[3]);
                    *(v4u*)(rowp + bj * 128) = w;
                }
            }
    }
};
template <bool NORM> struct EpiGate {
    static constexpr bool PERM = true, AFTER_DRAIN = false;
    bf16* G; const float* rstd; const float* nw; bool dry;
    __device__ __forceinline__ void operator()(const pg8::f32x4 (&acc)[2][2][4][2], const pg8::Unit& u, int wr, int wc, int fr, int fq) const {
        const int row0 = u.pm * 256 + wr * 64 + fr; const int c0 = u.pn * 256 + wc * 32 + 8 * fq;
        f32x4 wv[2][2];
        if (NORM) {
#pragma unroll
            for (int bj = 0; bj < 2; ++bj) { wv[bj][0] = *(const f32x4*)(nw + ((c0 + bj * 128) & 511)); wv[bj][1] = *(const f32x4*)(nw + ((c0 + bj * 128) & 511) + 4); }
        }
#pragma unroll
        for (int ai = 0; ai < 2; ++ai)
#pragma unroll
            for (int m = 0; m < 4; ++m) {
                const int row = row0 + ai * 128 + m * 16;
                bf16* rowp = G + (size_t)row * 2048 + c0;
                float rs = 1.0f;
                if (NORM) { const f32x4* sp = (const f32x4*)(rstd + ((size_t)row * 4 + (c0 >> 9)) * 32); f32x4 a4 = sp[0];
#pragma unroll
                    for (int q = 1; q < 8; ++q) a4 += sp[q];
                    rs = 1.0f / sqrtf(((a4[0] + a4[1]) + (a4[2] + a4[3])) * (1.0f / 512.0f) + EPS); }
#pragma unroll
                for (int bj = 0; bj < 2; ++bj) {
                    const pg8::f32x4 a = acc[ai][bj][m][0], b = acc[ai][bj][m][1];
                    const v4u on = *(const v4u*)(rowp + bj * 128);
                    float o[8] = {bflo(on.x), bfhi(on.x), bflo(on.y), bfhi(on.y), bflo(on.z), bfhi(on.z), bflo(on.w), bfhi(on.w)};
                    if (NORM) {
#pragma unroll
                        for (int i = 0; i < 4; ++i) { o[i] *= rs * wv[bj][0][i]; o[4 + i] *= rs * wv[bj][1][i]; }
                    }
                    v4u w;
                    w.x = pk2(o[0] * silu_f(a[0]), o[1] * silu_f(a[1])); w.y = pk2(o[2] * silu_f(a[2]), o[3] * silu_f(a[3]));
                    w.z = pk2(o[4] * silu_f(b[0]), o[5] * silu_f(b[1])); w.w = pk2(o[6] * silu_f(b[2]), o[7] * silu_f(b[3]));
                    if (!dry) *(v4u*)(rowp + bj * 128) = w;
                }
            }
    }
};
struct EpiRes {
    static constexpr bool PERM = true, AFTER_DRAIN = false;
    const float* xin; float* xout; const float* gate; bool dry;
    __device__ __forceinline__ void operator()(const pg8::f32x4 (&acc)[2][2][4][2], const pg8::Unit& u, int wr, int wc, int fr, int fq) const {
        const int row0 = u.pm * 256 + wr * 64 + fr; const int c0 = u.pn * 256 + wc * 32 + 8 * fq; const int b = u.pm >> 4;
        f32x4 gv[2][2];
#pragma unroll
        for (int bj = 0; bj < 2; ++bj) { gv[bj][0] = *(const f32x4*)(gate + b * 3072 + c0 + bj * 128); gv[bj][1] = *(const f32x4*)(gate + b * 3072 + c0 + bj * 128 + 4); }
#pragma unroll
        for (int ai = 0; ai < 2; ++ai)
#pragma unroll
            for (int m = 0; m < 4; ++m) {
                const size_t off = (size_t)(row0 + ai * 128 + m * 16) * 1024 + c0;
#pragma unroll
                for (int bj = 0; bj < 2; ++bj) {
                    const f32x4 x0 = *(const f32x4*)(xin + off + bj * 128), x1 = *(const f32x4*)(xin + off + bj * 128 + 4);
                    const pg8::f32x4 a = acc[ai][bj][m][0], b2 = acc[ai][bj][m][1];
                    f32x4 o0, o1;
#pragma unroll
                    for (int i = 0; i < 4; ++i) { o0[i] = x0[i] + gv[bj][0][i] * a[i]; o1[i] = x1[i] + gv[bj][1][i] * b2[i]; }
                    if (!dry) { *(f32x4*)(xout + off + bj * 128) = o0; *(f32x4*)(xout + off + bj * 128 + 4) = o1; }
                }
            }
    }
};

template <int MODE> __device__ __forceinline__ int dest_row(int n) {
    if (MODE == 1 && n < 4096) { const int d = n & 63, dp = d & 31; return (n & ~63) + 8 * (dp >> 2) + 4 * (d >> 5) + (dp & 3); }
    return n;
}
template <int MODE> __device__ __forceinline__ void p0_transpose_item(const float* W, int ld, int K, bf16* WT, int nblk, LAS float* scr, int item, int lane) {
    const int kb = item / nblk, nb = item % nblk, k0 = 64 * kb, n0 = 32 * nb;
#pragma unroll 8
    for (int i = 0; i < 32; ++i) { const int kk = 2 * i + (lane >> 5); scr[kk * 33 + (lane & 31)] = W[(size_t)(k0 + kk) * ld + n0 + (lane & 31)]; }
    LDS_WAIT(); asm volatile("" ::: "memory");
    const int c = lane & 7;
#pragma unroll
    for (int j = 0; j < 4; ++j) { const int n = (lane >> 3) + 8 * j; const LAS float* s = scr + (8 * c) * 33 + n;
        v4u o; o.x = pk2(s[0 * 33], s[1 * 33]); o.y = pk2(s[2 * 33], s[3 * 33]); o.z = pk2(s[4 * 33], s[5 * 33]); o.w = pk2(s[6 * 33], s[7 * 33]);
        *(v4u*)(WT + (size_t)dest_row<MODE>(n0 + n) * K + k0 + 8 * c) = o; }
    LDS_WAIT(); asm volatile("" ::: "memory");
}
__device__ __forceinline__ void norm_row_mod(const float* xrow, const float* g, const float* modb, bf16* orow, int lane) {
    const f32x4* xr = (const f32x4*)xrow + lane;
    f32x4 v[4]; float s = 0.f;
#pragma unroll
    for (int j = 0; j < 4; ++j) { v[j] = xr[64 * j]; s += (v[j][0] * v[j][0] + v[j][1] * v[j][1]) + (v[j][2] * v[j][2] + v[j][3] * v[j][3]); }
    const float rstd = 1.0f / sqrtf(wave_sum(s) * (1.0f / DM) + EPS);
    unsigned long long* o8 = (unsigned long long*)orow + lane;
#pragma unroll
    for (int j = 0; j < 4; ++j) {
        const f32x4 gg = ((const f32x4*)g)[lane + 64 * j], sh = ((const f32x4*)modb)[lane + 64 * j], sc = ((const f32x4*)(modb + 1024))[lane + 64 * j];
        float y[4];
#pragma unroll
        for (int i = 0; i < 4; ++i) y[i] = v[j][i] * rstd * gg[i] * (1.0f + sc[i]) + sh[i];
        o8[64 * j] = (unsigned long long)pk2(y[0], y[1]) | ((unsigned long long)pk2(y[2], y[3]) << 32);
    }
}

__device__ __forceinline__ pg8::f32x4 mfma16(bf16x8 a, bf16x8 b, pg8::f32x4 c) { return __builtin_amdgcn_mfma_f32_16x16x32_bf16(a, b, c, 0, 0, 0); }

#ifndef STOP_AFTER
#define STOP_AFTER 99
#endif
#ifndef DUP_PHASE
#define DUP_PHASE -1
#endif
#ifndef DUP_N
#define DUP_N 2
#endif
#define PHASE_LOOP(k) for (int rep_ = 0; rep_ < ((DUP_PHASE == (k)) ? DUP_N : 1); ++rep_)
#define DRY(k) (DUP_PHASE == (k) && rep_ > 0)

__global__ void __launch_bounds__(NTHREADS, 2) fwd_mega(Args args) {
    extern __shared__ __attribute__((aligned(16))) unsigned char lds_raw[];
    cg::grid_group grid = cg::this_grid();
    LAS unsigned char* lds = (LAS unsigned char*)lds_raw;
    const int G = gridDim.x, bx = blockIdx.x;
    const int vcu = (G % 8 == 0) ? (bx % 8) * (G / 8) + bx / 8 : bx;
    const int NGW = G * NWAVES;
#define FRESH_IDS() int tid_ = threadIdx.x; asm volatile("" : "+v"(tid_)); const int tid = tid_, lane = tid & 63, wid = __builtin_amdgcn_readfirstlane(tid >> 6), gw = bx * NWAVES + wid; (void)gw; (void)lane; (void)tid
    unsigned char* ws = args.ws;
    unsigned char* outb = (unsigned char*)args.out;
    if (ws == nullptr) grid.sync();
    volatile LAS unsigned* bst = (volatile LAS unsigned*)(lds + LDS_BYTES - 64);
    if (threadIdx.x < 2) bst[threadIdx.x] = 0u;
    __syncthreads();
    const XcdBarrier gbar = xcd_barrier_post((unsigned*)(ws + WS_BAR), bst);
#define GSYNC() xcd_barrier(gbar)
    const float* x = (const float*)args.in[0];
    const float* cvec = (const float*)args.in[1];
    const int* positions = (const int*)args.in[2];
    const float* ada_w = (const float*)args.in[3];
    const float* ada_b = (const float*)args.in[4];
    const float* norm_g = (const float*)args.in[5];
    const float* da_w_in = (const float*)args.in[6];
    const float* lq1 = (const float*)args.in[7];
    const float* lk1 = (const float*)args.in[8];
    const float* lq2 = (const float*)args.in[9];
    const float* lk2 = (const float*)args.in[10];
    const float* subln_w = (const float*)args.in[11];
    const float* da_w_out = (const float*)args.in[12];
    const float* gla_w_in = (const float*)args.in[13];
    const float* gla_w_gate_up = (const float*)args.in[14];
    const float* gla_b_gate = (const float*)args.in[15];
    const float* gla_norm_w = (const float*)args.in[16];
    const float* gla_w_out = (const float*)args.in[17];
    const float* final_g = (const float*)args.in[18];
    float* mod = (float*)(ws + WS_MOD);
    bf16* WgT = (bf16*)(ws + WS_WGT);
    bf16* W0t = (bf16*)(ws + WS_W0T); bf16* Wo0t = (bf16*)(ws + WS_WO0T); bf16* W1t = (bf16*)(ws + WS_W1T); bf16* Wo1t = (bf16*)(ws + WS_WO1T);
    float* rope = (float*)(ws + WS_ROPE);
    bf16* H0 = (bf16*)(outb + OUT_H0);
    bf16* Qb = (bf16*)(ws + WS_Q); bf16* Kb = (bf16*)(ws + WS_K); bf16* Vb = (bf16*)(ws + WS_V);

    {
        FRESH_IDS();
        LAS float* red = (LAS float*)lds;
        for (int item = bx; item < 96; item += G) {
            const int layer = item / 48, cgp = item % 48;
            const float* W = ada_w + (size_t)layer * 1024 * 3072 + cgp * 64 + lane;
            float a0 = 0.f, a1 = 0.f, a2 = 0.f, a3 = 0.f;
#pragma unroll 8
            for (int k = 128 * wid; k < 128 * wid + 128; ++k) {
                const float w = W[(size_t)k * 3072];
                a0 += cvec[k] * w; a1 += cvec[1024 + k] * w; a2 += cvec[2048 + k] * w; a3 += cvec[3072 + k] * w;
            }
            red[(wid * 4 + 0) * 64 + lane] = a0; red[(wid * 4 + 1) * 64 + lane] = a1; red[(wid * 4 + 2) * 64 + lane] = a2; red[(wid * 4 + 3) * 64 + lane] = a3;
            __syncthreads();
            if (tid < 256) {
                const int b = tid >> 6; float s = 0.f;
#pragma unroll
                for (int w = 0; w < 8; ++w) s += red[(w * 4 + b) * 64 + lane];
                mod[(size_t)(layer * 4 + b) * 3072 + cgp * 64 + lane] = s + ada_b[layer * 3072 + cgp * 64 + lane];
            }
            __syncthreads();
        }
        LAS float* scr = (LAS float*)(lds + wid * 16384);
        constexpr int I_W0 = 16 * 256, I_W1 = 16 * 192, I_WO = 32 * 32, NITEMS = I_W0 + I_W1 + 2 * I_WO;
        for (int it = gw; it < NITEMS; it += NGW) {
            int r = it;
            if (r < I_W0) { p0_transpose_item<1>(da_w_in, 8192, 1024, W0t, 256, scr, r, lane); continue; } r -= I_W0;
            if (r < I_W1) { p0_transpose_item<0>(gla_w_in, 6160, 1024, W1t, 192, scr, r, lane); continue; } r -= I_W1;
            if (r < I_WO) { p0_transpose_item<0>(da_w_out, 1024, 2048, Wo0t, 32, scr, r, lane); continue; } r -= I_WO;
            p0_transpose_item<0>(gla_w_out, 1024, 2048, Wo1t, 32, scr, r, lane);
        }
        const int gt = bx * NTHREADS + tid, NGT = G * NTHREADS;
        for (int id = gt; id < 16 * 1024; id += NGT) { const int r = id & 15, k = id >> 4; WgT[r * 1024 + k] = (bf16)f2bf(gla_w_in[(size_t)k * 6160 + 6144 + r]); }
        for (int id = gt; id < M * 32; id += NGT) {
            const int row = id >> 5, i = id & 31;
            const float inv = __builtin_amdgcn_exp2f(-(float)i * (13.287712379549449f / 32.0f));
            const float ang = (float)positions[row] * inv;
            const double t = (double)ang * 0.15915494309189535; const float frc = (float)(t - __builtin_rint(t));
            f32x2 cs; cs[0] = __builtin_amdgcn_cosf(frc); cs[1] = __builtin_amdgcn_sinf(frc);
            *(f32x2*)(rope + (size_t)id * 2) = cs;
        }
    }
    GSYNC();
    PHASE_LOOP(0) { FRESH_IDS(); for (int m = gw; m < M; m += NGW) norm_row_mod(x + (size_t)m * DM, norm_g, mod + (size_t)(m >> 12) * 3072, H0 + (size_t)m * DM, lane);
    GSYNC(); }
#if STOP_AFTER >= 1
    PHASE_LOOP(1) {
        pg8::Gemm g{H0, W0t, M, 6144, 1024}; pg8::StaticOrder S; S.init(M, 6144, G, bx);
        EpiQKV0 E{Qb, Kb, Vb, rope};
        pg8::gemm_phase<EpiQKV0, pg8::StaticOrder, true, true>(lds, g, S, E);
    GSYNC(); }
    PHASE_LOOP(2) {
        float lam;
        { FRESH_IDS(); const float p1 = wave_sum(lq1[lane] * lk1[lane]), p2 = wave_sum(lq2[lane] * lk2[lane]); lam = __builtin_bit_cast(float, __builtin_amdgcn_readfirstlane(__builtin_bit_cast(int, __expf(p1) - __expf(p2) + 0.2f))); }
        bf16* Osc = (bf16*)(outb + OUT_OSC + (size_t)bx * 131072);
        for (int v = vcu; v < 256; v += G) {
            const int bh = v >> 2, b = bh >> 4, h16 = bh & 15, s = v & 3;
#define DA_REF(R, idx_) do { const int gi_ = (idx_) >> 1, mp_ = (idx_) & 1; const int qb_ = (gi_ >> 1) * 8 + ((gi_ & 1) ? 7 - s : s); \
                const size_t row0_ = (size_t)b * SEQ + (size_t)qb_ * 256; const int h32_ = 2 * h16 + mp_; \
                R.Q = Qb + row0_ * 2048 + h32_ * 64; R.K = Kb + (size_t)b * SEQ * 2048 + h32_ * 64; R.V = Vb + (size_t)b * SEQ * 2048 + h16 * 128; R.O = Osc + mp_ * 32768; R.P0 = qb_ * 256; } while (0)
            da::BlockRef cur, nxt; da::Seam S;
            DA_REF(cur, 0);
            da::prime(cur, (char*)lds_raw, S);
            for (int idx = 0; idx < 8; ++idx) {
                const int nidx = idx + 1 < 8 ? idx + 1 : idx;
                DA_REF(nxt, nidx);
                da::block(cur, nxt, (char*)lds_raw, S);
                if (idx & 1) {
                    VM_WAIT(); __syncthreads(); __builtin_amdgcn_fence(__ATOMIC_ACQUIRE, "agent");
                    FRESH_IDS();
                    const int gi = idx >> 1, qb = (gi >> 1) * 8 + ((gi & 1) ? 7 - s : s);
                    const size_t row0 = (size_t)b * SEQ + (size_t)qb * 256;
                    const int row = tid >> 1, vh = tid & 1;
                    const bf16* p0 = Osc + row * 128 + vh * 64; const bf16* p1 = Osc + 32768 + row * 128 + vh * 64;
                    float d[64]; float ss = 0.f;
#pragma unroll
                    for (int c8 = 0; c8 < 8; ++c8) {
                        const v4u a = *(const v4u*)(p0 + 8 * c8), bq = *(const v4u*)(p1 + 8 * c8);
                        d[8 * c8 + 0] = bflo(a.x) - lam * bflo(bq.x); d[8 * c8 + 1] = bfhi(a.x) - lam * bfhi(bq.x);
                        d[8 * c8 + 2] = bflo(a.y) - lam * bflo(bq.y); d[8 * c8 + 3] = bfhi(a.y) - lam * bfhi(bq.y);
                        d[8 * c8 + 4] = bflo(a.z) - lam * bflo(bq.z); d[8 * c8 + 5] = bfhi(a.z) - lam * bfhi(bq.z);
                        d[8 * c8 + 6] = bflo(a.w) - lam * bflo(bq.w); d[8 * c8 + 7] = bfhi(a.w) - lam * bfhi(bq.w);
                    }
#pragma unroll
                    for (int i = 0; i < 64; ++i) ss += d[i] * d[i];
                    ss += __shfl_xor(ss, 1);
                    const float rs = 0.8f / sqrtf(ss * (1.0f / 128.0f) + EPS);
                    bf16* op = Qb + (row0 + row) * 2048 + h16 * 128 + vh * 64;
#pragma unroll
                    for (int c8 = 0; c8 < 8; ++c8) {
                        const f32x4 w0 = *(const f32x4*)(subln_w + vh * 64 + 8 * c8), w1 = *(const f32x4*)(subln_w + vh * 64 + 8 * c8 + 4);
                        v4u w;
                        w.x = pk2(d[8 * c8 + 0] * rs * w0[0], d[8 * c8 + 1] * rs * w0[1]); w.y = pk2(d[8 * c8 + 2] * rs * w0[2], d[8 * c8 + 3] * rs * w0[3]);
                        w.z = pk2(d[8 * c8 + 4] * rs * w1[0], d[8 * c8 + 5] * rs * w1[1]); w.w = pk2(d[8 * c8 + 6] * rs * w1[2], d[8 * c8 + 7] * rs * w1[3]);
                        if (!DRY(2)) *(v4u*)(op + 8 * c8) = w;
                    }
                }
                cur = nxt;
            }
#undef DA_REF
        }
    GSYNC(); }
    PHASE_LOOP(3) {
        pg8::Gemm g{H0, W0t + (size_t)6144 * 1024, M, 2048, 1024}; pg8::StaticOrder S; S.init(M, 2048, G, bx);
        EpiGate<false> E{Qb, nullptr, nullptr, DRY(3)};
        pg8::gemm_phase<EpiGate<false>, pg8::StaticOrder, true, true>(lds, g, S, E);
    GSYNC(); }
    PHASE_LOOP(4) {
        pg8::Gemm g{Qb, Wo0t, M, 1024, 2048}; pg8::StaticOrder S; S.init(M, 1024, G, bx);
        EpiRes E{x, args.out, mod + 2048, false};
        pg8::gemm_phase<EpiRes, pg8::StaticOrder, true, true>(lds, g, S, E);
    GSYNC(); }
#else
    { FRESH_IDS(); for (size_t i = (size_t)bx * NTHREADS + tid; i < (size_t)M * DM / 4; i += (size_t)G * NTHREADS) ((f32x4*)args.out)[i] = ((const f32x4*)x)[i]; }
    GSYNC();
#endif
#if STOP_AFTER >= 2
    bf16* H1 = (bf16*)(ws + WS_H1); bf16* Q1 = (bf16*)(ws + WS_Q1); bf16* K1 = (bf16*)(ws + WS_K1); bf16* V1 = (bf16*)(ws + WS_V1); bf16* keT = (bf16*)(ws + WS_KET);
    bf16* attnb = (bf16*)(ws + WS_ATTN); float* decb = (float*)(ws + WS_DEC); float* sspart = (float*)(ws + WS_SSP);
    PHASE_LOOP(5) { FRESH_IDS(); for (int m = gw; m < M; m += NGW) norm_row_mod(args.out + (size_t)m * DM, norm_g + 1024, mod + (size_t)(4 + (m >> 12)) * 3072, H1 + (size_t)m * DM, lane);
    GSYNC(); }
    PHASE_LOOP(6) {
        pg8::Gemm g{H1, W1t, M, 4096, 1024}; pg8::StaticOrder S; S.init(M, 4096, G, bx);
        EpiQKV1 E{Q1, K1, V1};
        pg8::gemm_phase<EpiQKV1, pg8::StaticOrder, true, true>(lds, g, S, E);
    GSYNC(); }
    PHASE_LOOP(7) {
        FRESH_IDS();
        const int fr = lane & 15, fq = lane >> 4;
        LAS unsigned char* qdL = lds; LAS unsigned char* kiL = lds + 33792;
        LAS float* glow = (LAS float*)(lds + 67584); LAS float* red = (LAS float*)(lds + 71680); LAS float* pref = (LAS float*)(lds + 104448);
        LAS float* wgL = (LAS float*)(lds + 112640);
        bf16x8 bfr[4];
#pragma unroll
        for (int ks = 0; ks < 4; ++ks) bfr[ks] = *(const bf16x8*)(WgT + fr * 1024 + 128 * wid + 32 * ks + 8 * fq);
        bf16x8 afr[4][4]; v2u qw[8], kw[8];
#define P7_LOAD(it_) do { const int b_ = (it_) >> 8, n_ = ((it_) >> 2) & 63, h_ = (it_) & 3; const size_t r0_ = (size_t)b_ * SEQ + (size_t)n_ * 64; \
            _Pragma("unroll") for (int ks = 0; ks < 4; ++ks) _Pragma("unroll") for (int ti = 0; ti < 4; ++ti) afr[ks][ti] = *(const bf16x8*)(H1 + (r0_ + 16 * ti + fr) * 1024 + 128 * wid + 32 * ks + 8 * fq); \
            _Pragma("unroll") for (int rr = 0; rr < 8; ++rr) { const size_t ro_ = (r0_ + 8 * wid + rr) * 1024 + h_ * 256 + 4 * lane; qw[rr] = *(const v2u*)(Q1 + ro_); kw[rr] = *(const v2u*)(K1 + ro_); } } while (0)
        int hprev = -1;
        if (vcu < 1024) P7_LOAD(vcu);
        for (int item = vcu; item < 1024; item += G) {
            const int b = item >> 8, n = (item >> 2) & 63, h = item & 3, bhn = (b * 4 + h) * 64 + n;
            const size_t r0 = (size_t)b * SEQ + (size_t)n * 64;
            const int col = h * 256 + 4 * lane;
            if (h != hprev) {
                LBAR();
#pragma unroll
                for (int q = 0; q < 2; ++q) { const int idx = tid + 512 * q, r = idx >> 6, c4 = idx & 63; *(LAS f32x4*)(wgL + r * 256 + 4 * c4) = *(const f32x4*)(gla_w_gate_up + r * 1024 + h * 256 + 4 * c4); }
                hprev = h;
            }
            {
                pg8::f32x4 gacc[4];
#pragma unroll
                for (int ti = 0; ti < 4; ++ti) gacc[ti] = (pg8::f32x4){0.f, 0.f, 0.f, 0.f};
#pragma unroll
                for (int ks = 0; ks < 4; ++ks)
#pragma unroll
                    for (int ti = 0; ti < 4; ++ti) gacc[ti] = mfma16(afr[ks][ti], bfr[ks], gacc[ti]);
#pragma unroll
                for (int ti = 0; ti < 4; ++ti)
#pragma unroll
                    for (int e = 0; e < 4; ++e) red[wid * 1024 + (16 * ti + 4 * fq + e) * 16 + fr] = gacc[ti][e];
            }
            LBAR();
#pragma unroll
            for (int q = 0; q < 2; ++q) { const int idx = tid + 512 * q; float s = 0.f;
#pragma unroll
                for (int w = 0; w < 8; ++w) s += red[w * 1024 + idx];
                glow[idx] = s; }
            LBAR();
            f32x4 bc[8];
            {
                const f32x4 bg = *(const f32x4*)(gla_b_gate + col);
#pragma unroll
                for (int rr = 0; rr < 8; ++rr) bc[rr] = bg;
#pragma unroll
                for (int rq = 0; rq < 4; ++rq) {
                    f32x4 w4[4];
#pragma unroll
                    for (int i = 0; i < 4; ++i) w4[i] = *(const LAS f32x4*)(wgL + (4 * rq + i) * 256 + 4 * lane);
#pragma unroll
                    for (int rh = 0; rh < 2; ++rh) {
                        f32x4 g4[4];
#pragma unroll
                        for (int rr = 0; rr < 4; ++rr) g4[rr] = *(const LAS f32x4*)(glow + (8 * wid + 4 * rh + rr) * 16 + 4 * rq);
#pragma unroll
                        for (int rr = 0; rr < 4; ++rr)
#pragma unroll
                            for (int i = 0; i < 4; ++i) bc[4 * rh + rr] += w4[i] * g4[rr][i];
                    }
                }
                f32x4 run = (f32x4){0.f, 0.f, 0.f, 0.f};
#pragma unroll
                for (int rr = 0; rr < 8; ++rr) {
#pragma unroll
                    for (int i = 0; i < 4; ++i) { const float gg = bc[rr][i]; const float ls = fminf(gg, 0.f) - __logf(1.0f + __expf(-fabsf(gg))); run[i] += ls * (1.0f / 16.0f); }
                    bc[rr] = run;
                }
                *(LAS f32x4*)(pref + wid * 256 + 4 * lane) = run;
            }
            LBAR();
            f32x4 off = (f32x4){0.f, 0.f, 0.f, 0.f}, tot = (f32x4){0.f, 0.f, 0.f, 0.f};
#pragma unroll
            for (int w = 0; w < 8; ++w) { const f32x4 p = *(const LAS f32x4*)(pref + w * 256 + 4 * lane); tot += p; if (w < wid) off += p; }
            unsigned kew[4][4];
#pragma unroll
            for (int rr = 0; rr < 8; ++rr) {
                const size_t ro = (r0 + 8 * wid + rr) * 1024 + col;
                const float qv[4] = {bflo(qw[rr].x), bfhi(qw[rr].x), bflo(qw[rr].y), bfhi(qw[rr].y)}, kv[4] = {bflo(kw[rr].x), bfhi(kw[rr].x), bflo(kw[rr].y), bfhi(kw[rr].y)};
                float qd[4], ki[4], ke[4];
#pragma unroll
                for (int i = 0; i < 4; ++i) { const float bb = bc[rr][i] + off[i]; qd[i] = qv[i] * __expf(bb) * 0.0625f; ki[i] = kv[i] * __expf(-bb); ke[i] = kv[i] * __expf(tot[i] - bb); }
                v2u qo; qo.x = pk2(qd[0], qd[1]); qo.y = pk2(qd[2], qd[3]);
                v2u ko; ko.x = pk2(ki[0], ki[1]); ko.y = pk2(ki[2], ki[3]);
                if (!DRY(7)) *(v2u*)(Q1 + ro) = qo;
                *(LAS v2u*)(qdL + (8 * wid + rr) * 528 + 8 * lane) = qo;
                *(LAS v2u*)(kiL + (8 * wid + rr) * 528 + 8 * lane) = ko;
#pragma unroll
                for (int i = 0; i < 4; ++i) { const unsigned hb = f2bf(ke[i]); if (rr & 1) kew[i][rr >> 1] |= hb << 16; else kew[i][rr >> 1] = hb; }
            }
#pragma unroll
            for (int i = 0; i < 4; ++i) { v4u w; w.x = kew[i][0]; w.y = kew[i][1]; w.z = kew[i][2]; w.w = kew[i][3];
                if (!DRY(7)) *(v4u*)(keT + ((size_t)bhn * 256 + 4 * lane + i) * 64 + 8 * wid) = w; }
            if (wid == 0 && !DRY(7)) { f32x4 dv;
#pragma unroll
                for (int i = 0; i < 4; ++i) dv[i] = __expf(tot[i]);
                *(f32x4*)(decb + (size_t)bhn * 256 + 4 * lane) = dv; }
            if (item + G < 1024) P7_LOAD(item + G);
            LBAR();
            {
                const int ti = wid >> 1;
#pragma unroll
                for (int tjj = 0; tjj < 2; ++tjj) {
                    const int tj = (wid & 1) * 2 + tjj;
                    pg8::f32x4 acc0 = (pg8::f32x4){0.f, 0.f, 0.f, 0.f}, acc1 = acc0;
                    if (tj <= ti) {
#pragma unroll
                        for (int kh = 0; kh < 2; ++kh) {
                            bf16x8 kfv[4], qfv[4];
#pragma unroll
                            for (int ks = 0; ks < 4; ++ks) {
                                kfv[ks] = *(const LAS bf16x8*)(kiL + (16 * tj + fr) * 528 + (32 * (4 * kh + ks) + 8 * fq) * 2);
                                qfv[ks] = *(const LAS bf16x8*)(qdL + (16 * ti + fr) * 528 + (32 * (4 * kh + ks) + 8 * fq) * 2);
                            }
                            __builtin_amdgcn_sched_barrier(0);
#pragma unroll
                            for (int ks = 0; ks < 4; ks += 2) { acc0 = mfma16(kfv[ks], qfv[ks], acc0); acc1 = mfma16(kfv[ks + 1], qfv[ks + 1], acc1); }
                            __builtin_amdgcn_sched_barrier(0);
                        }
                    }
                    const int i = 16 * ti + fr, j0 = 16 * tj + 4 * fq;
                    float o[4];
#pragma unroll
                    for (int e = 0; e < 4; ++e) o[e] = (j0 + e <= i) ? acc0[e] + acc1[e] : 0.f;
                    v2u w; w.x = pk2(o[0], o[1]); w.y = pk2(o[2], o[3]);
                    if (!DRY(7)) *(v2u*)(attnb + ((size_t)bhn * 64 + i) * 64 + j0) = w;
                }
            }
            LBAR();
        }
#undef P7_LOAD
    GSYNC(); }
    PHASE_LOOP(8) {
        FRESH_IDS();
        const int fr = lane & 15, fq = lane >> 4;
        LAS unsigned char* qdL = lds; LAS unsigned char* keL = lds + 33792; LAS unsigned char* vTL = lds + 70656; LAS unsigned char* atL = lds + 75264;
        LAS float* decL = (LAS float*)(lds + 84480); LAS unsigned char* sTL = lds + 85504;
        for (int item = vcu; item < 256; item += G) {
            const int bhh = item >> 4, vs = item & 15, b = bhh >> 2, h = bhh & 3;
            pg8::f32x4 S[2][2];
#pragma unroll
            for (int i = 0; i < 2; ++i)
#pragma unroll
                for (int j = 0; j < 2; ++j) S[i][j] = (pg8::f32x4){0.f, 0.f, 0.f, 0.f};
            LBAR();
            for (int i = tid; i < 16896 / 4; i += NTHREADS) ((LAS unsigned*)sTL)[i] = 0u;
            v4u rqA[4], rkA[4], raA; v2u rvA; f32x4 rdA;
#define P8_LOAD(X, nn) do { const size_t r0_ = (size_t)b * SEQ + (size_t)(nn) * 64; const size_t blk_ = (size_t)(bhh * 64 + (nn)); \
                _Pragma("unroll") for (int q = 0; q < 4; ++q) { const int p = tid + 512 * q; rq##X[q] = *(const v4u*)(Q1 + (r0_ + (p >> 5)) * 1024 + h * 256 + 8 * (p & 31)); rk##X[q] = *(const v4u*)(keT + blk_ * 16384 + (size_t)p * 8); } \
                rv##X = *(const v2u*)(V1 + (r0_ + (tid >> 3)) * 2048 + h * 512 + vs * 32 + 4 * (tid & 7)); \
                ra##X = *(const v4u*)(attnb + blk_ * 4096 + (size_t)tid * 8); \
                rd##X = *(const f32x4*)(decb + blk_ * 256 + 4 * (tid & 63)); } while (0)
#define P8_STAGE(X) do { \
                _Pragma("unroll") for (int q = 0; q < 4; ++q) { const int p = tid + 512 * q; *(LAS v4u*)(qdL + (p >> 5) * 528 + (p & 31) * 16) = rq##X[q]; *(LAS v4u*)(keL + (p >> 3) * 144 + (p & 7) * 16) = rk##X[q]; } \
                { const int j = tid >> 3, c4 = 4 * (tid & 7); \
                  *(LAS unsigned short*)(vTL + (c4 + 0) * 144 + j * 2) = (unsigned short)(rv##X.x & 0xffffu); *(LAS unsigned short*)(vTL + (c4 + 1) * 144 + j * 2) = (unsigned short)(rv##X.x >> 16); \
                  *(LAS unsigned short*)(vTL + (c4 + 2) * 144 + j * 2) = (unsigned short)(rv##X.y & 0xffffu); *(LAS unsigned short*)(vTL + (c4 + 3) * 144 + j * 2) = (unsigned short)(rv##X.y >> 16); } \
                *(LAS v4u*)(atL + (tid >> 3) * 144 + (tid & 7) * 16) = ra##X; \
                *(LAS f32x4*)(decL + 4 * (tid & 63)) = rd##X; } while (0)
            const int ib = wid >> 1, vb = wid & 1;
#define P8_STEP(n, XL, XS) do { \
                P8_LOAD(XL, ((n) + 1 < 64 ? (n) + 1 : 63)); \
                const size_t r0 = (size_t)b * SEQ + (size_t)(n) * 64; \
                  \
                pg8::f32x4 oa0 = (pg8::f32x4){0.f, 0.f, 0.f, 0.f}, oa1 = oa0; \
                bf16x8 vfr[2][2], vfo[2], afv[2], kfv[2][2]; f32x4 dcv[2]; \
                { bf16x8 sfv[4], qfv[4]; \
                  _Pragma("unroll") for (int ks = 0; ks < 4; ++ks) { \
                    sfv[ks] = *(const LAS bf16x8*)(sTL + (16 * vb + fr) * 528 + (32 * ks + 8 * fq) * 2); \
                    qfv[ks] = *(const LAS bf16x8*)(qdL + (16 * ib + fr) * 528 + (32 * ks + 8 * fq) * 2); } \
                  __builtin_amdgcn_sched_barrier(0); \
                  _Pragma("unroll") for (int ks = 0; ks < 4; ks += 2) { oa0 = mfma16(sfv[ks], qfv[ks], oa0); oa1 = mfma16(sfv[ks + 1], qfv[ks + 1], oa1); } \
                  __builtin_amdgcn_sched_barrier(0); } \
                { bf16x8 sfv[4], qfv[4]; \
                  _Pragma("unroll") for (int ks = 0; ks < 4; ++ks) { \
                    sfv[ks] = *(const LAS bf16x8*)(sTL + (16 * vb + fr) * 528 + (32 * (ks + 4) + 8 * fq) * 2); \
                    qfv[ks] = *(const LAS bf16x8*)(qdL + (16 * ib + fr) * 528 + (32 * (ks + 4) + 8 * fq) * 2); } \
                  __builtin_amdgcn_sched_barrier(0); \
                  _Pragma("unroll") for (int ks = 0; ks < 4; ks += 2) { oa0 = mfma16(sfv[ks], qfv[ks], oa0); oa1 = mfma16(sfv[ks + 1], qfv[ks + 1], oa1); } } \
                _Pragma("unroll") for (int ks = 0; ks < 2; ++ks) { \
                    vfo[ks] = *(const LAS bf16x8*)(vTL + (16 * vb + fr) * 144 + (32 * ks + 8 * fq) * 2); \
                    afv[ks] = *(const LAS bf16x8*)(atL + (16 * ib + fr) * 144 + (32 * ks + 8 * fq) * 2); \
                    _Pragma("unroll") for (int v2 = 0; v2 < 2; ++v2) vfr[v2][ks] = *(const LAS bf16x8*)(vTL + (16 * v2 + fr) * 144 + (32 * ks + 8 * fq) * 2); \
                    _Pragma("unroll") for (int dbi = 0; dbi < 2; ++dbi) kfv[dbi][ks] = *(const LAS bf16x8*)(keL + (16 * (2 * wid + dbi) + fr) * 144 + (32 * ks + 8 * fq) * 2); } \
                _Pragma("unroll") for (int dbi = 0; dbi < 2; ++dbi) dcv[dbi] = *(const LAS f32x4*)(decL + 16 * (2 * wid + dbi) + 4 * fq); \
                __builtin_amdgcn_sched_barrier(0); \
                  \
                oa0 = mfma16(vfo[0], afv[0], oa0); oa1 = mfma16(vfo[1], afv[1], oa1); \
                _Pragma("unroll") for (int dbi = 0; dbi < 2; ++dbi) _Pragma("unroll") for (int v2 = 0; v2 < 2; ++v2) { \
                    _Pragma("unroll") for (int e = 0; e < 4; ++e) S[dbi][v2][e] *= dcv[dbi][e]; \
                    S[dbi][v2] = mfma16(kfv[dbi][0], vfr[v2][0], S[dbi][v2]); S[dbi][v2] = mfma16(kfv[dbi][1], vfr[v2][1], S[dbi][v2]); } \
                { const pg8::f32x4 oacc = oa0 + oa1; v2u w; w.x = pk2(oacc[0], oacc[1]); w.y = pk2(oacc[2], oacc[3]); \
                  if (!DRY(8)) *(v2u*)(V1 + (r0 + 16 * ib + fr) * 2048 + h * 512 + vs * 32 + 16 * vb + 4 * fq) = w; \
                  float sq = (oacc[0] * oacc[0] + oacc[1] * oacc[1]) + (oacc[2] * oacc[2] + oacc[3] * oacc[3]); sq += __shfl_xor(sq, 16); sq += __shfl_xor(sq, 32); \
                  if (!DRY(8)) sspart[((r0 + 16 * ib + fr) * 4 + h) * 32 + vs * 2 + vb] = sq; } \
                LBAR(); \
                _Pragma("unroll") for (int dbi = 0; dbi < 2; ++dbi) _Pragma("unroll") for (int v2 = 0; v2 < 2; ++v2) { v2u w; w.x = pk2(S[dbi][v2][0], S[dbi][v2][1]); w.y = pk2(S[dbi][v2][2], S[dbi][v2][3]); \
                        *(LAS v2u*)(sTL + (16 * v2 + fr) * 528 + (16 * (2 * wid + dbi) + 4 * fq) * 2) = w; } \
                P8_STAGE(XS); \
                LBAR(); } while (0)
            P8_LOAD(A, 0);
            P8_STAGE(A);
            LBAR();
#pragma unroll 1
            for (int n = 0; n < 64; ++n) {
                P8_STEP(n, A, A);
            }
#undef P8_LOAD
#undef P8_STAGE
#undef P8_STEP
        }
    GSYNC(); }
    PHASE_LOOP(10) {
        pg8::Gemm g{H1, W1t + (size_t)4096 * 1024, M, 2048, 1024}; pg8::StaticOrder S; S.init(M, 2048, G, bx);
        EpiGate<true> E{V1, sspart, gla_norm_w, DRY(10)};
        pg8::gemm_phase<EpiGate<true>, pg8::StaticOrder, true, true>(lds, g, S, E);
    GSYNC(); }
    PHASE_LOOP(11) {
        pg8::Gemm g{V1, Wo1t, M, 1024, 2048}; pg8::StaticOrder S; S.init(M, 1024, G, bx);
        EpiRes E{args.out, args.out, mod + 4 * 3072 + 2048, DRY(11)};
        pg8::gemm_phase<EpiRes, pg8::StaticOrder, true, true>(lds, g, S, E);
    GSYNC(); }
#endif
    if (DUP_PHASE == 20) { for (int i = 0; i < 10; ++i) GSYNC(); }
    { FRESH_IDS();
    for (int m = gw; m < M; m += NGW) {
        f32x4* xr = (f32x4*)(args.out + (size_t)m * DM) + lane;
        f32x4 v[4]; float s = 0.f;
#pragma unroll
        for (int j = 0; j < 4; ++j) { v[j] = xr[64 * j]; s += (v[j][0] * v[j][0] + v[j][1] * v[j][1]) + (v[j][2] * v[j][2] + v[j][3] * v[j][3]); }
        const float rstd = 1.0f / sqrtf(wave_sum(s) * (1.0f / DM) + EPS);
#pragma unroll
        for (int j = 0; j < 4; ++j) { const f32x4 gg = ((const f32x4*)final_g)[lane + 64 * j]; f32x4 o;
#pragma unroll
            for (int i = 0; i < 4; ++i) o[i] = v[j][i] * rstd * gg[i];
            xr[64 * j] = o; }
    } }
}

extern "C" void kernel_launch(void* const* d_in, const int* in_sizes, int n_in, void* d_out, int out_size, void* d_ws, size_t ws_size, hipStream_t stream) {
    static int grid = 0;
    if (grid == 0) {
        if (n_in != 19 || out_size != M * DM || ws_size < WS_END) { fprintf(stderr, "kernel_launch: unexpected shapes (n_in %d out %d ws %zu)\n", n_in, out_size, ws_size); grid = -1; return; }
        int dev = 0, cus = 0, per_cu = 0;
        hipGetDevice(&dev); hipDeviceGetAttribute(&cus, hipDeviceAttributeMultiprocessorCount, dev);
        hipFuncSetAttribute((const void*)fwd_mega, hipFuncAttributeMaxDynamicSharedMemorySize, LDS_BYTES);
        hipOccupancyMaxActiveBlocksPerMultiprocessor(&per_cu, (const void*)fwd_mega, NTHREADS, LDS_BYTES);
        (void)hipGetLastError();
        if (per_cu < 1) per_cu = 1;
        grid = cus;
        if (grid > 256) grid = 256;
    }
    if (grid < 0) return;
    if (hipMemsetAsync((char*)d_ws + WS_BAR, 0, WS_BAR_BYTES, stream) != hipSuccess) { fprintf(stderr, "memset failed\n"); return; }
    Args a{};
    for (int i = 0; i < 19; ++i) a.in[i] = d_in[i];
    a.out = (float*)d_out; a.ws = (unsigned char*)d_ws;
    void* kargs[] = {&a};
    hipError_t e = hipLaunchCooperativeKernel((const void*)fwd_mega, dim3(grid), dim3(NTHREADS), kargs, LDS_BYTES, stream);
    if (e != hipSuccess) fprintf(stderr, "cooperative launch failed: %s (grid %d)\n", hipGetErrorString(e), grid);
}
```
